# Optimizing an MI355X kernel written in HIP

```python
import math
import jax
import jax.numpy as jnp
from jax import lax
import numpy as np

D_MODEL = 1024
BATCH = 8
SEQ = 4096
DEPTH = 2

HEAD_DIM = 64
D_FF = 2816
ROPE_THETA = 10000.0
NORM_EPS = 1e-6
NEG_INF = -1e30

A_HEADS = 4
A_VDIM = 2 * HEAD_DIM
A_OUT = A_HEADS * A_VDIM
A_QBLOCK = 128
A_SIZES = (2 * A_HEADS * HEAD_DIM, 2 * A_HEADS * HEAD_DIM, A_OUT)
A_COLS = sum(A_SIZES)

B_HEADS = 8
B_DIM = B_HEADS * HEAD_DIM
B_W_RANK = 64
B_A_RANK = 64
B_G_RANK = 128
B_GN_EPS = 64e-5
B_SIZES = (B_DIM, B_DIM, B_DIM, B_W_RANK, B_A_RANK, B_G_RANK)
B_COLS = sum(B_SIZES)
AB_COLS = A_COLS + B_COLS

C_HEADS = 8
C_KV_GROUPS = 2
C_HPG = C_HEADS // C_KV_GROUPS
C_OUT = C_HEADS * HEAD_DIM
C_KVW = C_KV_GROUPS * HEAD_DIM
CMP_BLOCK = 32
CMP_STRIDE = 16
CMP_HIDDEN = 256
SLC_BLOCK = 64
N_SELECT = 16
WINDOW = 512
C_QBLOCK = 64
FORCE_BONUS = 1e4
C_SIZES = (C_OUT, C_KVW, C_KVW, C_KVW, C_KVW, C_KVW, C_KVW, 3 * C_HEADS)
C_COLS = sum(C_SIZES)

D_HEADS = 4
D_QK = 64
D_V = 128
D_OUT = D_HEADS * D_V
D_CHUNK = 64
D_CONV = 4
D_SIZES = (D_HEADS * D_QK, D_HEADS * D_QK, D_OUT, D_HEADS, D_HEADS, D_OUT)
D_COLS = sum(D_SIZES)
CD_COLS = C_COLS + D_COLS

kernel_name = 'hybrid_diffattn_rwkv7_nsa_mlstm_macaron'


def rmsnorm(x, w, eps=NORM_EPS):
    xf = x.astype(jnp.float32)
    y = xf * lax.rsqrt(jnp.mean(xf * xf, axis=-1, keepdims=True) + eps)
    return (y * w.astype(jnp.float32)).astype(x.dtype)


def split_cols(p, sizes):
    return jnp.split(p, [int(c) for c in np.cumsum(sizes)[:-1]], axis=-1)


def rope_tables(pos):
    inv = jnp.asarray(ROPE_THETA ** (-np.arange(0, HEAD_DIM, 2, dtype=np.float32) / HEAD_DIM), jnp.float32)
    ang = pos[:, None] * inv[None, :]
    ang = jnp.concatenate([ang, ang], axis=-1)
    return jnp.cos(ang), jnp.sin(ang)


def apply_rope(x, cos, sin):
    x1, x2 = jnp.split(x, 2, axis=-1)
    rot = jnp.concatenate([-x2, x1], axis=-1)
    return (x * cos + rot * sin).astype(x.dtype)


def swiglu(x, wg, wu, wd):
    return (jax.nn.silu(x @ wg) * (x @ wu)) @ wd


def lambda_init(layer):
    return 0.8 - 0.6 * math.exp(-0.3 * layer)


def diff_attention(qa, ka, va, lam, subln_w, lam_init, cos, sin):
    B, T, _ = qa.shape
    q = apply_rope(qa.reshape(B, T, A_HEADS, 2, HEAD_DIM).transpose(0, 2, 3, 1, 4), cos, sin) * (HEAD_DIM ** -0.5)
    k = apply_rope(ka.reshape(B, T, A_HEADS, 2, HEAD_DIM).transpose(0, 2, 3, 1, 4), cos, sin)
    v = va.reshape(B, T, A_HEADS, A_VDIM).transpose(0, 2, 1, 3)
    lam32 = lam.astype(jnp.float32)
    lam_full = jnp.exp(jnp.sum(lam32[0] * lam32[1])) - jnp.exp(jnp.sum(lam32[2] * lam32[3])) + lam_init
    nb = T // A_QBLOCK
    qb = q.reshape(B, A_HEADS, 2, nb, A_QBLOCK, HEAD_DIM).transpose(3, 0, 1, 2, 4, 5)
    kpos = jnp.arange(T)

    def block(args):
        qi, i = args
        s = jnp.einsum('bhcqd,bhckd->bhcqk', qi, k).astype(jnp.float32)
        qpos = i * A_QBLOCK + jnp.arange(A_QBLOCK)
        mask = kpos[None, :] <= qpos[:, None]
        p = jax.nn.softmax(jnp.where(mask, s, NEG_INF), axis=-1)
        attn = p[:, :, 0] - lam_full * p[:, :, 1]
        return jnp.einsum('bhqk,bhke->bhqe', attn.astype(v.dtype), v)

    o = lax.map(block, (qb, jnp.arange(nb)))
    o = o.transpose(1, 0, 3, 2, 4).reshape(B, T, A_HEADS, A_VDIM)
    o = rmsnorm(o, subln_w) * (1.0 - lam_init)
    return o.reshape(B, T, A_OUT)


def rwkv7_time_mix(p, mu, w0, w2, a0, a2, g2, k_k, k_a, r_k, ln_w, ln_b):
    B, T, _ = p.shape
    prev = jnp.pad(p[:, :-1], ((0, 0), (1, 0), (0, 0)))
    xm = p + (prev - p) * mu
    r, k, v, wl, al, gl = split_cols(xm, B_SIZES)
    w = -jax.nn.softplus(-(w0 + jnp.tanh(wl) @ w2)) - 0.5
    a = jax.nn.sigmoid(a0 + al @ a2)
    g = jax.nn.sigmoid(gl) @ g2

    def heads(z):
        return z.reshape(B, T, B_HEADS, HEAD_DIM).astype(jnp.float32)

    kk = heads(k * k_k)
    kk = kk * lax.rsqrt(jnp.sum(kk * kk, axis=-1, keepdims=True) + 1e-12)
    k = k * (1.0 + (a - 1.0) * k_a)
    r_h, k_h, v_h, a_h = heads(r), heads(k), heads(v), heads(a)
    decay = jnp.exp(-jnp.exp(heads(w)))

    def step(S, inp):
        r_t, w_t, k_t, v_t, kk_t, a_t = inp
        S = (S * w_t[:, :, None, :]
             - jnp.einsum('bhvk,bhk->bhv', S, kk_t)[..., None] * (kk_t * a_t)[:, :, None, :]
             + v_t[..., None] * k_t[:, :, None, :])
        return S, jnp.einsum('bhvk,bhk->bhv', S, r_t)

    def tm(z):
        return z.transpose(1, 0, 2, 3)

    S0 = jnp.zeros((B, B_HEADS, HEAD_DIM, HEAD_DIM), jnp.float32)
    _, y = lax.scan(step, S0, (tm(r_h), tm(decay), tm(k_h), tm(v_h), tm(kk), tm(a_h)))
    y = y.transpose(1, 0, 2, 3)
    mean = jnp.mean(y, axis=-1, keepdims=True)
    var = jnp.mean(jnp.square(y - mean), axis=-1, keepdims=True)
    y = (y - mean) * lax.rsqrt(var + B_GN_EPS) * ln_w.reshape(B_HEADS, HEAD_DIM) + ln_b.reshape(B_HEADS, HEAD_DIM)
    bonus = jnp.sum(r_h * k_h * r_k, axis=-1, keepdims=True) * v_h
    out = (y + bonus).reshape(B, T, B_DIM).astype(p.dtype)
    return out * g


def compress_blocks(z, pe, w1, w2):
    B, G, T, d = z.shape
    n_cmp = (T - CMP_BLOCK) // CMP_STRIDE + 1
    idx = CMP_STRIDE * np.arange(n_cmp)[:, None] + np.arange(CMP_BLOCK)[None, :]
    blocks = (z[:, :, idx] + pe).reshape(B, G, n_cmp, CMP_BLOCK * d)
    return jax.nn.gelu(blocks @ w1) @ w2


def selection_map(n_cmp, n_slc):
    c0 = CMP_STRIDE * np.arange(n_cmp)[:, None]
    s0 = SLC_BLOCK * np.arange(n_slc)[None, :]
    shared = np.clip(np.minimum(c0 + CMP_BLOCK, s0 + SLC_BLOCK) - np.maximum(c0, s0), 0, None)
    return jnp.asarray(shared / CMP_BLOCK, jnp.float32)


def native_sparse_attention(q, kc, vc, ks, vs, kw, vw, gate_logits,
                            pe_k, w1_k, w2_k, pe_v, w1_v, w2_v, cos, sin):
    B, T, _ = q.shape
    dt = q.dtype
    q = apply_rope(q.reshape(B, T, C_KV_GROUPS, C_HPG, HEAD_DIM).transpose(0, 2, 3, 1, 4), cos, sin) * (HEAD_DIM ** -0.5)

    def groups(z):
        return z.reshape(B, T, C_KV_GROUPS, HEAD_DIM).transpose(0, 2, 1, 3)

    kc, vc, ks, vs, kw, vw = [groups(z) for z in (kc, vc, ks, vs, kw, vw)]
    ks = apply_rope(ks, cos, sin)
    kw = apply_rope(kw, cos, sin)
    n_cmp = (T - CMP_BLOCK) // CMP_STRIDE + 1
    cmp_end = CMP_STRIDE * np.arange(n_cmp) + CMP_BLOCK - 1
    ccos, csin = rope_tables(jnp.asarray(cmp_end, jnp.float32))
    k_cmp = apply_rope(compress_blocks(kc, pe_k, w1_k, w2_k), ccos, csin)
    v_cmp = compress_blocks(vc, pe_v, w1_v, w2_v)
    n_slc = T // SLC_BLOCK
    n_sel = min(N_SELECT, n_slc)
    sel_map = selection_map(n_cmp, n_slc)
    ks_blocks = ks.reshape(B, C_KV_GROUPS, n_slc, SLC_BLOCK, HEAD_DIM)
    vs_blocks = vs.reshape(B, C_KV_GROUPS, n_slc, SLC_BLOCK, HEAD_DIM)
    kw_pad = jnp.pad(kw, ((0, 0), (0, 0), (WINDOW, 0), (0, 0)))
    vw_pad = jnp.pad(vw, ((0, 0), (0, 0), (WINDOW, 0), (0, 0)))
    gates = jax.nn.sigmoid(gate_logits).reshape(B, T, C_KV_GROUPS, C_HPG, 3).transpose(0, 2, 3, 1, 4)
    b_idx = jnp.arange(B)[:, None, None, None]
    g_idx = jnp.arange(C_KV_GROUPS)[None, :, None, None]
    blk = jnp.arange(n_slc)
    cmp_end_j = jnp.asarray(cmp_end)

    def block(i):
        s0 = i * C_QBLOCK
        t = s0 + jnp.arange(C_QBLOCK)
        qi = lax.dynamic_slice_in_dim(q, s0, C_QBLOCK, axis=3)
        mc = cmp_end_j[None, :] <= t[:, None]
        sc = jnp.einsum('bghqd,bgnd->bghqn', qi, k_cmp).astype(jnp.float32)
        pc = jnp.where(mc, jax.nn.softmax(jnp.where(mc, sc, NEG_INF), axis=-1), 0.0)
        o_cmp = jnp.einsum('bghqn,bgne->bghqe', pc.astype(dt), v_cmp)
        imp = jnp.einsum('bghqn,nj->bgqj', pc, sel_map)
        cur = t // SLC_BLOCK
        forced = (blk[None, :] == 0) | (blk[None, :] == cur[:, None]) | (blk[None, :] == cur[:, None] - 1)
        valid = blk[None, :] * SLC_BLOCK <= t[:, None]
        score = jnp.where(valid, imp + jnp.where(forced, FORCE_BONUS, 0.0), NEG_INF)
        _, sel = lax.top_k(score, n_sel)
        kg = ks_blocks[b_idx, g_idx, sel]
        vg = vs_blocks[b_idx, g_idx, sel]
        pos = sel[..., None] * SLC_BLOCK + jnp.arange(SLC_BLOCK)
        ms = (pos <= t[:, None, None])[:, :, None]
        ss = jnp.where(ms, jnp.einsum('bghqd,bgqnkd->bghqnk', qi, kg).astype(jnp.float32), NEG_INF)
        ps = jax.nn.softmax(ss.reshape(B, C_KV_GROUPS, C_HPG, C_QBLOCK, -1), axis=-1).reshape(ss.shape)
        o_slc = jnp.einsum('bghqnk,bgqnke->bghqe', ps.astype(dt), vg)
        kwi = lax.dynamic_slice_in_dim(kw_pad, s0, C_QBLOCK + WINDOW, axis=2)
        vwi = lax.dynamic_slice_in_dim(vw_pad, s0, C_QBLOCK + WINDOW, axis=2)
        wpos = s0 - WINDOW + jnp.arange(C_QBLOCK + WINDOW)
        mw = (wpos[None, :] <= t[:, None]) & (wpos[None, :] > t[:, None] - WINDOW) & (wpos[None, :] >= 0)
        sw = jnp.einsum('bghqd,bgkd->bghqk', qi, kwi).astype(jnp.float32)
        pw = jax.nn.softmax(jnp.where(mw, sw, NEG_INF), axis=-1)
        o_win = jnp.einsum('bghqk,bgke->bghqe', pw.astype(dt), vwi)
        gi = lax.dynamic_slice_in_dim(gates, s0, C_QBLOCK, axis=3)
        return gi[..., 0:1] * o_cmp + gi[..., 1:2] * o_slc + gi[..., 2:3] * o_win

    o = lax.map(block, jnp.arange(T // C_QBLOCK))
    return o.transpose(1, 0, 4, 2, 3, 5).reshape(B, T, C_OUT)


def causal_conv(x, w, b):
    K, T = w.shape[0], x.shape[1]
    xp = jnp.pad(x, ((0, 0), (K - 1, 0), (0, 0)))
    return sum(xp[:, j:j + T] * w[j] for j in range(K)) + b


def mlstm(q, k, v, ig, fg, og, conv_w, conv_b, ig_b, fg_b, norm_w):
    B, T, _ = q.shape
    qk = jax.nn.silu(causal_conv(jnp.concatenate([q, k], axis=-1), conv_w, conv_b))
    q, k = qk[..., :D_HEADS * D_QK], qk[..., D_HEADS * D_QK:]
    nc = T // D_CHUNK

    def chunks(z, dim):
        return z.astype(jnp.float32).reshape(B, nc, D_CHUNK, D_HEADS, dim).transpose(1, 0, 3, 2, 4)

    def gate_chunks(z):
        return z.reshape(B, nc, D_CHUNK, D_HEADS).transpose(1, 0, 3, 2)

    qc = chunks(q, D_QK) * (D_QK ** -0.5)
    kc = chunks(k, D_QK)
    vc = chunks(v, D_V)
    li = gate_chunks((ig + ig_b).astype(jnp.float32))
    lf = gate_chunks(jax.nn.log_sigmoid((fg + fg_b).astype(jnp.float32)))
    causal = jnp.tril(jnp.ones((D_CHUNK, D_CHUNK), bool))

    def step(carry, inp):
        C, n, m = carry
        qs, ks, vs, lis, lfs = inp
        b = jnp.cumsum(lfs, axis=-1)
        dmat = jnp.where(causal, b[..., :, None] - b[..., None, :] + lis[..., None, :], -jnp.inf)
        m_s = jnp.maximum(b + m[..., None], jnp.max(dmat, axis=-1))
        carry_w = jnp.exp(b + m[..., None] - m_s)
        sqk = jnp.einsum('bhsd,bhrd->bhsr', qs, ks) * jnp.exp(dmat - m_s[..., None])
        num = carry_w[..., None] * jnp.einsum('bhsd,bhde->bhse', qs, C) + jnp.einsum('bhsr,bhre->bhse', sqk, vs)
        den = carry_w * jnp.einsum('bhsd,bhd->bhs', qs, n) + jnp.sum(sqk, axis=-1)
        h = num / jnp.maximum(jnp.abs(den), jnp.exp(-m_s))[..., None]
        b_last = b[..., -1]
        g = b_last[..., None] - b + lis
        m_new = jnp.maximum(b_last + m, jnp.max(g, axis=-1))
        decay_c = jnp.exp(b_last + m - m_new)
        wr = jnp.exp(g - m_new[..., None])
        C = decay_c[..., None, None] * C + jnp.einsum('bhr,bhrd,bhre->bhde', wr, ks, vs)
        n = decay_c[..., None] * n + jnp.einsum('bhr,bhrd->bhd', wr, ks)
        return (C, n, m_new), h

    init = (jnp.zeros((B, D_HEADS, D_QK, D_V), jnp.float32),
            jnp.zeros((B, D_HEADS, D_QK), jnp.float32),
            jnp.zeros((B, D_HEADS), jnp.float32))
    _, h = lax.scan(step, init, (qc, kc, vc, li, lf))
    h = h.transpose(1, 0, 3, 2, 4).reshape(B, T, D_HEADS, D_V)
    h = rmsnorm(h, norm_w.reshape(D_HEADS, D_V)).reshape(B, T, D_OUT)
    return h.astype(og.dtype) * jax.nn.sigmoid(og)


def setup_inputs(seed: int = 0) -> dict:
    key = jax.random.key(seed)
    keys = iter(jax.random.split(key, 48))

    def nrm(shape, scale):
        return jax.random.normal(next(keys), shape, jnp.float32) * scale

    def gain(shape):
        return 1.0 + nrm(shape, 0.02)

    L, E, O = DEPTH, (DEPTH + 1) // 2, DEPTH // 2
    d, f = D_MODEL, D_FF
    return {
        'x': nrm((BATCH, SEQ, d), 1.0),
        'ffa_norm': gain((L, d)),
        'ffa_gate': nrm((L, d, f), d ** -0.5),
        'ffa_up': nrm((L, d, f), d ** -0.5),
        'ffa_down': nrm((L, f, d), f ** -0.5),
        'mix_norm': gain((L, d)),
        'ffb_norm': gain((L, d)),
        'ffb_gate': nrm((L, d, f), d ** -0.5),
        'ffb_up': nrm((L, d, f), d ** -0.5),
        'ffb_down': nrm((L, f, d), f ** -0.5),
        'ab_w_in': nrm((E, d, AB_COLS), d ** -0.5),
        'ab_w_out': nrm((E, A_OUT + B_DIM, d), (A_OUT + B_DIM) ** -0.5),
        'diff_lam': nrm((E, 4, HEAD_DIM), 0.1),
        'diff_subln': gain((E, A_VDIM)),
        'rwkv_mu': jax.random.uniform(next(keys), (E, B_COLS), jnp.float32),
        'rwkv_w0': jnp.linspace(-6.0, 1.0, B_DIM, dtype=jnp.float32)[None, :] + nrm((E, B_DIM), 0.1),
        'rwkv_w2': nrm((E, B_W_RANK, B_DIM), B_W_RANK ** -0.5),
        'rwkv_a0': nrm((E, B_DIM), 0.1),
        'rwkv_a2': nrm((E, B_A_RANK, B_DIM), B_A_RANK ** -0.5),
        'rwkv_g2': nrm((E, B_G_RANK, B_DIM), B_G_RANK ** -0.5),
        'rwkv_kk': 0.85 + nrm((E, B_DIM), 0.05),
        'rwkv_ka': 1.0 + nrm((E, B_DIM), 0.05),
        'rwkv_rk': nrm((E, B_HEADS, HEAD_DIM), 0.1),
        'rwkv_lnw': gain((E, B_DIM)),
        'rwkv_lnb': nrm((E, B_DIM), 0.02),
        'cd_w_in': nrm((O, d, CD_COLS), d ** -0.5),
        'cd_w_out': nrm((O, C_OUT + D_OUT, d), (C_OUT + D_OUT) ** -0.5),
        'nsa_pe_k': nrm((O, CMP_BLOCK, HEAD_DIM), 0.1),
        'nsa_w1_k': nrm((O, CMP_BLOCK * HEAD_DIM, CMP_HIDDEN), (CMP_BLOCK * HEAD_DIM) ** -0.5),
        'nsa_w2_k': nrm((O, CMP_HIDDEN, HEAD_DIM), CMP_HIDDEN ** -0.5),
        'nsa_pe_v': nrm((O, CMP_BLOCK, HEAD_DIM), 0.1),
        'nsa_w1_v': nrm((O, CMP_BLOCK * HEAD_DIM, CMP_HIDDEN), (CMP_BLOCK * HEAD_DIM) ** -0.5),
        'nsa_w2_v': nrm((O, CMP_HIDDEN, HEAD_DIM), CMP_HIDDEN ** -0.5),
        'mlstm_conv_w': nrm((O, D_CONV, 2 * D_HEADS * D_QK), 0.5),
        'mlstm_conv_b': nrm((O, 2 * D_HEADS * D_QK), 0.02),
        'mlstm_ig_b': -2.0 + nrm((O, D_HEADS), 0.1),
        'mlstm_fg_b': jnp.linspace(3.0, 6.0, D_HEADS, dtype=jnp.float32)[None, :] + nrm((O, D_HEADS), 0.1),
        'mlstm_norm': gain((O, D_OUT)),
        'final_norm': gain((d,)),
    }


def reference(x, ffa_norm, ffa_gate, ffa_up, ffa_down, mix_norm, ffb_norm, ffb_gate, ffb_up, ffb_down,
              ab_w_in, ab_w_out, diff_lam, diff_subln,
              rwkv_mu, rwkv_w0, rwkv_w2, rwkv_a0, rwkv_a2, rwkv_g2, rwkv_kk, rwkv_ka, rwkv_rk, rwkv_lnw, rwkv_lnb,
              cd_w_in, cd_w_out, nsa_pe_k, nsa_w1_k, nsa_w2_k, nsa_pe_v, nsa_w1_v, nsa_w2_v,
              mlstm_conv_w, mlstm_conv_b, mlstm_ig_b, mlstm_fg_b, mlstm_norm, final_norm):
    T = x.shape[1]
    cos, sin = rope_tables(jnp.arange(T, dtype=jnp.float32))
    for layer in range(DEPTH):
        j = layer // 2
        x = x + 0.5 * swiglu(rmsnorm(x, ffa_norm[layer]), ffa_gate[layer], ffa_up[layer], ffa_down[layer])
        h = rmsnorm(x, mix_norm[layer])
        if layer % 2 == 0:
            p = h @ ab_w_in[j]
            qa, ka, va = split_cols(p[..., :A_COLS], A_SIZES)
            oa = diff_attention(qa, ka, va, diff_lam[j], diff_subln[j], lambda_init(layer), cos, sin)
            ob = rwkv7_time_mix(p[..., A_COLS:], rwkv_mu[j], rwkv_w0[j], rwkv_w2[j], rwkv_a0[j], rwkv_a2[j],
                                rwkv_g2[j], rwkv_kk[j], rwkv_ka[j], rwkv_rk[j], rwkv_lnw[j], rwkv_lnb[j])
            mix = jnp.concatenate([oa, ob], axis=-1) @ ab_w_out[j]
        else:
            p = h @ cd_w_in[j]
            cq, ckc, cvc, cks, cvs, ckw, cvw, cg = split_cols(p[..., :C_COLS], C_SIZES)
            dq, dk, dv, di, df, dog = split_cols(p[..., C_COLS:], D_SIZES)
            oc = native_sparse_attention(cq, ckc, cvc, cks, cvs, ckw, cvw, cg,
                                         nsa_pe_k[j], nsa_w1_k[j], nsa_w2_k[j],
                                         nsa_pe_v[j], nsa_w1_v[j], nsa_w2_v[j], cos, sin)
            od = mlstm(dq, dk, dv, di, df, dog, mlstm_conv_w[j], mlstm_conv_b[j],
                       mlstm_ig_b[j], mlstm_fg_b[j], mlstm_norm[j])
            mix = jnp.concatenate([oc, od], axis=-1) @ cd_w_out[j]
        x = x + mix
        x = x + 0.5 * swiglu(rmsnorm(x, ffb_norm[layer]), ffb_gate[layer], ffb_up[layer], ffb_down[layer])
    return rmsnorm(x, final_norm)
```

```cpp
#include <hip/hip_runtime.h>
#include <hip/hip_cooperative_groups.h>
#include <stdint.h>
#include <cstdio>
#include <cstring>
namespace cg = cooperative_groups;

#ifndef MEGA
#define MEGA 1
#endif

typedef unsigned short bf16_t;
using bf16x8 = __attribute__((ext_vector_type(8))) short;
using f32x4 = __attribute__((ext_vector_type(4))) float;
using f32x2 = __attribute__((ext_vector_type(2))) float;

#define NTHR 256
constexpr int T_ = 4096, NB_ = 8, DM = 1024, FF = 2816, MTOK = NB_ * T_;
constexpr int LDAB = 3328, LDCD = 2944;
constexpr size_t MiB = 1048576;
constexpr size_t OFF_WGU = 0;
constexpr size_t SZ_WGU = 11 * MiB;
constexpr size_t OFF_WD = 44 * MiB;
constexpr size_t SZ_WD = 5767168;
constexpr size_t OFF_WINAB = 66 * MiB;
constexpr size_t OFF_WINCD = OFF_WINAB + 6815744;
constexpr size_t OFF_WOUTAB = OFF_WINCD + 6029312;
constexpr size_t OFF_WOUTCD = OFF_WOUTAB + 2 * MiB;
constexpr size_t OFF_W1K = OFF_WOUTCD + 2 * MiB;
constexpr size_t OFF_W1V = OFF_W1K + MiB;
constexpr size_t OFF_W2K = OFF_W1V + MiB;
constexpr size_t OFF_W2V = OFF_W2K + 65536;
constexpr size_t OFF_ROPE = OFF_W2V + 65536;
constexpr size_t OFF_BIAS1 = OFF_ROPE + MiB;
constexpr size_t OFF_MISC = OFF_BIAS1 + 4096;
constexpr size_t OFF_XBAR = OFF_MISC + 4096;
constexpr size_t OFF_A = 88 * MiB;
constexpr size_t OFF_B = 152 * MiB;
constexpr size_t OFF_C = 360 * MiB;
constexpr size_t OFF_Y = 400 * MiB;
constexpr size_t OFF_VTS = OFF_C;
constexpr size_t OFF_VTW = OFF_C + 8 * MiB;
constexpr size_t OFF_HIDK = OFF_C + 16 * MiB;
constexpr size_t OFF_HIDV = OFF_C + 18 * MiB;
constexpr size_t OFF_KCMP = OFF_C + 20 * MiB;
constexpr size_t OFF_VCMPT = OFF_C + 21 * MiB;

struct TJob { const float* src; bf16_t* dst; int K, N, mode, tstart; };
struct Params {
  const float* in[39];
  float* out;
  unsigned char* ws;
};
typedef const __attribute__((address_space(4))) Params* KP;
__device__ __forceinline__ KP kp_launder(KP p) { asm volatile("" : "+s"(p)); return p; }
__device__ __forceinline__ int tidx() { int t = threadIdx.x; asm volatile("" : "+v"(t)); return t; }
__device__ __forceinline__ int bidx() { int t = blockIdx.x; asm volatile("" : "+s"(t)); return t; }
constexpr int TR_FFN = 16 * 44 * 3;
constexpr int TR_TOTAL = 4 * TR_FFN + 16 * 52 + 16 * 45 + 2 * 256 + 2 * 128 + 2 * 4;

__device__ __forceinline__ unsigned short f2bf(float f) {
  unsigned u = __float_as_uint(f); u += 0x7fffu + ((u >> 16) & 1u); return (unsigned short)(u >> 16);
}
__device__ __forceinline__ float bf2f(unsigned short h) { return __uint_as_float(((unsigned)h) << 16); }
__device__ __forceinline__ unsigned pack2(float a, float b) { unsigned r; asm("v_cvt_pk_bf16_f32 %0, %1, %2" : "=v"(r) : "v"(a), "v"(b)); return r; }
__device__ __forceinline__ uint2 pack4(float a, float b, float c, float d) { return make_uint2(pack2(a, b), pack2(c, d)); }
__device__ __forceinline__ float sigmoidf_(float x) { return 1.f / (1.f + __expf(-x)); }
__device__ __forceinline__ float softplusf_(float x) { return fmaxf(x, 0.f) + log1pf(__expf(-fabsf(x))); }
__device__ __forceinline__ float ftanhf_(float x) { float e = __expf(2.f * x); return 1.f - 2.f / (e + 1.f); }
__device__ __forceinline__ int swz(int row, int chunk) { return row * 128 + ((chunk ^ (row & 7)) << 4); }
__device__ __forceinline__ bf16x8 ldsfrag(const unsigned char* tile, int row, int chunk) {
  return *reinterpret_cast<const bf16x8*>(tile + swz(row, chunk));
}
__device__ __forceinline__ bf16x8 ldsfragP(const unsigned char* tile, int row, int s, int g) {
  const unsigned char* r = tile + row * 128 + (g & 1) * 8;
  int c0 = 4 * s + (g >> 1), c1 = c0 + 2, x = row & 7;
  uint2 a = *reinterpret_cast<const uint2*>(r + ((c0 ^ x) << 4));
  uint2 b = *reinterpret_cast<const uint2*>(r + ((c1 ^ x) << 4));
  union { uint4 u; bf16x8 v; } cv; cv.u = make_uint4(a.x, a.y, b.x, b.y); return cv.v;
}
__device__ __forceinline__ bf16x8 packfrag(const f32x4& a, const f32x4& b) {
  union { uint4 u; bf16x8 v; } cv;
  cv.u = make_uint4(pack2(a[0], a[1]), pack2(a[2], a[3]), pack2(b[0], b[1]), pack2(b[2], b[3])); return cv.v;
}
__device__ __forceinline__ bf16x8 u4frag(uint4 u) { union { uint4 u; bf16x8 v; } cv; cv.u = u; return cv.v; }

template <int CTRL>
__device__ __forceinline__ float dppf(float x) {
  return __int_as_float(__builtin_amdgcn_update_dpp(0, __float_as_int(x), CTRL, 0xF, 0xF, true));
}
__device__ __forceinline__ float red4(float x) { x += dppf<0xB1>(x); x += dppf<0x4E>(x); return x; }
__device__ __forceinline__ float red16(float x) { x = red4(x); x += dppf<0x124>(x); x += dppf<0x128>(x); return x; }

template <int CTRL, int RMASK>
__device__ __forceinline__ float dppo(float oldv, float x) {
  return __int_as_float(__builtin_amdgcn_update_dpp(__float_as_int(oldv), __float_as_int(x), CTRL, RMASK, 0xF, false));
}
__device__ __forceinline__ float wave_scan_add(float x) {
  x += dppo<0x111, 0xF>(0.f, x); x += dppo<0x112, 0xF>(0.f, x); x += dppo<0x114, 0xF>(0.f, x); x += dppo<0x118, 0xF>(0.f, x);
  x += dppo<0x142, 0xA>(0.f, x); x += dppo<0x143, 0xC>(0.f, x);
  return x;
}
__device__ __forceinline__ float wave_scan_max(float x) {
  x = fmaxf(x, dppo<0x111, 0xF>(-3e38f, x)); x = fmaxf(x, dppo<0x112, 0xF>(-3e38f, x));
  x = fmaxf(x, dppo<0x114, 0xF>(-3e38f, x)); x = fmaxf(x, dppo<0x118, 0xF>(-3e38f, x));
  x = fmaxf(x, dppo<0x142, 0xA>(-3e38f, x)); x = fmaxf(x, dppo<0x143, 0xC>(-3e38f, x));
  return x;
}
__device__ __forceinline__ float ex2(float x) { return __builtin_amdgcn_exp2f(x); }
#define MFMA(a, b, c) __builtin_amdgcn_mfma_f32_16x16x32_bf16(a, b, c, 0, 0, 0)

__device__ __forceinline__ void transpose_tile(KP P, int tile, unsigned char* smraw) {
  float* sm = reinterpret_cast<float*>(smraw);
  const int tid = tidx();
    TJob J;
    if (tile < 4 * TR_FFN) {
      int f = tile / TR_FFN, r = tile - f * TR_FFN, w = r / 704;
      int layer = f >> 1; bool bsel = f & 1;
      const float* g0 = bsel ? P->in[7] : P->in[2];
      const float* u0 = bsel ? P->in[8] : P->in[3];
      const float* d0 = bsel ? P->in[9] : P->in[4];
      J.src = (w == 0 ? g0 : (w == 1 ? u0 : d0)) + (size_t)layer * DM * FF;
      J.dst = reinterpret_cast<bf16_t*>(P->ws + (w < 2 ? OFF_WGU + f * SZ_WGU : OFF_WD + f * SZ_WD));
      J.K = (w < 2) ? DM : FF; J.N = (w < 2) ? FF : DM; J.mode = (w == 0) ? 1 : (w == 1 ? 2 : 0);
      J.tstart = f * TR_FFN + w * 704;
    } else {
      int r = tile - 4 * TR_FFN;
      if (r < 832) { J.src = P->in[10]; J.dst = reinterpret_cast<bf16_t*>(P->ws + OFF_WINAB); J.K = DM; J.N = 3328; J.tstart = 4 * TR_FFN; }
      else if (r < 1552) { J.src = P->in[25]; J.dst = reinterpret_cast<bf16_t*>(P->ws + OFF_WINCD); J.K = DM; J.N = 2848; J.tstart = 4 * TR_FFN + 832; }
      else if (r < 1808) { J.src = P->in[11]; J.dst = reinterpret_cast<bf16_t*>(P->ws + OFF_WOUTAB); J.K = DM; J.N = DM; J.tstart = 4 * TR_FFN + 1552; }
      else if (r < 2064) { J.src = P->in[26]; J.dst = reinterpret_cast<bf16_t*>(P->ws + OFF_WOUTCD); J.K = DM; J.N = DM; J.tstart = 4 * TR_FFN + 1808; }
      else if (r < 2192) { J.src = P->in[28]; J.dst = reinterpret_cast<bf16_t*>(P->ws + OFF_W1K); J.K = 2048; J.N = 256; J.tstart = 4 * TR_FFN + 2064; }
      else if (r < 2320) { J.src = P->in[31]; J.dst = reinterpret_cast<bf16_t*>(P->ws + OFF_W1V); J.K = 2048; J.N = 256; J.tstart = 4 * TR_FFN + 2192; }
      else if (r < 2324) { J.src = P->in[29]; J.dst = reinterpret_cast<bf16_t*>(P->ws + OFF_W2K); J.K = 256; J.N = 64; J.tstart = 4 * TR_FFN + 2320; }
      else { J.src = P->in[32]; J.dst = reinterpret_cast<bf16_t*>(P->ws + OFF_W2V); J.K = 256; J.N = 64; J.tstart = 4 * TR_FFN + 2324; }
      J.mode = 0;
    }
    int lt = tile - J.tstart;
    int nkt = J.K >> 6;
    int kt = lt % nkt, nt = lt / nkt;
    int k0 = kt * 64, n0 = nt * 64;
    for (int i = tid; i < 4096; i += NTHR) {
      int r = i >> 6, c = i & 63, n = n0 + c;
      sm[r * 65 + c] = (n < J.N) ? J.src[(size_t)(k0 + r) * J.N + n] : 0.f;
    }
    __syncthreads();
    for (int i = tid; i < 4096; i += NTHR) {
      int c = i >> 6, r = i & 63, n = n0 + c;
      if (n < J.N) {
        int drow = (J.mode == 0) ? n : ((n >> 5) * 64 + (n & 31) + (J.mode == 2 ? 32 : 0));
        J.dst[(size_t)drow * J.K + k0 + r] = f2bf(sm[r * 65 + c]);
      }
    }
    __syncthreads();
}

constexpr int TR_EARLY = 2112 + 832;
__device__ __forceinline__ int tr_early_tile(int v) { return v < 2112 ? v : v - 2112 + 4 * TR_FFN; }
__device__ __forceinline__ int tr_late_tile(int v) { return v < 3 * TR_FFN ? v + TR_FFN : v - 3 * TR_FFN + 4 * TR_FFN + 832; }

__device__ __forceinline__ void phase_prep(KP P, unsigned char* smraw) {
  const int tid = tidx();
  for (int v = bidx(); v < TR_EARLY; v += gridDim.x) transpose_tile(P, tr_early_tile(v), smraw);
  const int gtid = bidx() * NTHR + tid, gsz = gridDim.x * NTHR;
  float2* rope = reinterpret_cast<float2*>(P->ws + OFF_ROPE);
  for (int i = gtid; i < T_ * 32; i += gsz) {
    int t = i >> 5, d = i & 31;
    float inv = powf(10000.f, -(float)(2 * d) / 64.f);
    float ang = (float)t * inv;
    rope[i] = make_float2(cosf(ang), sinf(ang));
  }
  {
    bf16_t* w = reinterpret_cast<bf16_t*>(P->ws + OFF_WINCD) + (size_t)2848 * 1024;
    for (int i = gtid; i < 96 * 1024; i += gsz) w[i] = 0;
    bf16_t* a = reinterpret_cast<bf16_t*>(P->ws + OFF_W2K) + 64 * 256;
    bf16_t* b = reinterpret_cast<bf16_t*>(P->ws + OFF_W2V) + 64 * 256;
    for (int i = gtid; i < 64 * 256; i += gsz) { a[i] = 0; b[i] = 0; }
  }
  if (bidx() < 2) {
    const float* pe = (bidx() == 0) ? P->in[27] : P->in[30];
    const float* w1 = (bidx() == 0) ? P->in[28] : P->in[31];
    float acc = 0.f;
    for (int k = 0; k < 2048; ++k) acc += pe[k] * w1[(size_t)k * 256 + tid];
    reinterpret_cast<float*>(P->ws + OFF_BIAS1)[bidx() * 256 + tid] = acc;
  }
  if (bidx() == 2 && tid < 64) {
    const float* lam = P->in[12];
    float a = lam[tid] * lam[64 + tid], b = lam[128 + tid] * lam[192 + tid];
    for (int o = 32; o; o >>= 1) { a += __shfl_xor(a, o); b += __shfl_xor(b, o); }
    if (tid == 0) {
      float* misc = reinterpret_cast<float*>(P->ws + OFF_MISC);
      misc[0] = expf(a) - expf(b) + 0.2f;
    }
  }
  if (bidx() == 4) {
    unsigned* xb = reinterpret_cast<unsigned*>(P->ws + OFF_XBAR);
    for (int i = tid; i < 3456; i += NTHR) xb[i] = 0u;
  }
  if (bidx() == 3 && tid == 0) {
    unsigned* cnt = reinterpret_cast<unsigned*>(P->ws + OFF_MISC + 64);
    cnt[0] = 0; cnt[1] = 0; cnt[2] = 0; cnt[3] = 0;
  }
}

__device__ __forceinline__ void phase_rmsnorm(const float* __restrict__ src, const float* __restrict__ w, bf16_t* __restrict__ dst) {
  const int lane = tidx() & 63, wid = tidx() >> 6;
  for (int row = bidx() * 4 + wid; row < MTOK; row += gridDim.x * 4) {
    const float4* s4 = reinterpret_cast<const float4*>(src + (size_t)row * DM);
    float4 v[4]; float ss = 0.f;
#pragma unroll
    for (int i = 0; i < 4; ++i) { v[i] = s4[lane + 64 * i]; ss += v[i].x * v[i].x + v[i].y * v[i].y + v[i].z * v[i].z + v[i].w * v[i].w; }
    for (int o = 32; o; o >>= 1) ss += __shfl_xor(ss, o);
    float r = rsqrtf(ss * (1.f / DM) + 1e-6f);
#pragma unroll
    for (int i = 0; i < 4; ++i) {
      float4 ww = reinterpret_cast<const float4*>(w)[lane + 64 * i];
      uint2 o = pack4(v[i].x * r * ww.x, v[i].y * r * ww.y, v[i].z * r * ww.z, v[i].w * r * ww.w);
      *reinterpret_cast<uint2*>(dst + (size_t)row * DM + (lane + 64 * i) * 4) = o;
    }
  }
}
__device__ __forceinline__ void phase_finalnorm(float* __restrict__ x, const float* __restrict__ w) {
  const int lane = tidx() & 63, wid = tidx() >> 6;
  for (int row = bidx() * 4 + wid; row < MTOK; row += gridDim.x * 4) {
    float4* s4 = reinterpret_cast<float4*>(x + (size_t)row * DM);
    float4 v[4]; float ss = 0.f;
#pragma unroll
    for (int i = 0; i < 4; ++i) { v[i] = s4[lane + 64 * i]; ss += v[i].x * v[i].x + v[i].y * v[i].y + v[i].z * v[i].z + v[i].w * v[i].w; }
    for (int o = 32; o; o >>= 1) ss += __shfl_xor(ss, o);
    float r = rsqrtf(ss * (1.f / DM) + 1e-6f);
#pragma unroll
    for (int i = 0; i < 4; ++i) {
      float4 ww = reinterpret_cast<const float4*>(w)[lane + 64 * i];
      s4[lane + 64 * i] = make_float4(v[i].x * r * ww.x, v[i].y * r * ww.y, v[i].z * r * ww.z, v[i].w * r * ww.w);
    }
  }
}

struct ALoadPlain {
  const bf16_t* A; int lda;
  __device__ __forceinline__ const bf16_t* ptr(int row, int kt) const { return A + (size_t)row * lda + kt * 64; }
};
struct ALoadCmp {
  const bf16_t* p; int colbase;
  __device__ __forceinline__ const bf16_t* ptr(int row, int kt) const {
    int bg = row >> 8, n = row & 255, b = bg >> 1, g = bg & 1;
    int t = min(16 * n + kt, T_ - 1);
    return p + ((size_t)(b * T_ + t)) * LDCD + colbase + g * 64;
  }
};

__device__ __forceinline__ int swz32(int row, int chunk) { return row * 64 + ((chunk ^ ((-(row >> 2)) & 3)) << 4); }
template <class AF, class EPI>
__device__ __forceinline__ void gemm_tile(const AF& af, const bf16_t* __restrict__ Bt, int K, int tm, int tn,
                                          const EPI& epi, unsigned char* sm, bool pre_issued = false, int ntm = -1, int ntn = -1) {
  const int tid = tidx(), lane = tid & 63, wid = tid >> 6;
  const int wm = wid >> 1, wn = wid & 1, c16 = lane & 15, g = lane >> 4;
  const int lr = tid >> 2, lc = tid & 3;
  const int nk = K >> 5;
  f32x4 acc[4][8];
#pragma unroll
  for (int i = 0; i < 4; ++i)
#pragma unroll
    for (int j = 0; j < 8; ++j) acc[i][j] = f32x4{0.f, 0.f, 0.f, 0.f};
  const int gc = (lc ^ ((-(lr >> 2)) & 3)) * 8;
  const bf16_t* bp = Bt + (size_t)(tn * 128 + lr) * K + gc;
  const int row0 = tm * 256 + lr;
  typedef __attribute__((address_space(3))) unsigned* ldsp_t;
#define GLD(KT, BASE) { const int k_ = (KT); const int ko_ = (k_ & 1) * 32 + gc;                                \
    unsigned char* d_ = (BASE) + tid * 16;                                                                      \
    __builtin_amdgcn_global_load_lds((const unsigned*)(af.ptr(row0, k_ >> 1) + ko_), (ldsp_t)(d_), 16, 0, 0);             \
    __builtin_amdgcn_global_load_lds((const unsigned*)(af.ptr(row0 + 64, k_ >> 1) + ko_), (ldsp_t)(d_ + 4096), 16, 0, 0);  \
    __builtin_amdgcn_global_load_lds((const unsigned*)(af.ptr(row0 + 128, k_ >> 1) + ko_), (ldsp_t)(d_ + 8192), 16, 0, 0); \
    __builtin_amdgcn_global_load_lds((const unsigned*)(af.ptr(row0 + 192, k_ >> 1) + ko_), (ldsp_t)(d_ + 12288), 16, 0, 0);\
    __builtin_amdgcn_global_load_lds((const unsigned*)(bp + k_ * 32), (ldsp_t)(d_ + 16384), 16, 0, 0);                    \
    __builtin_amdgcn_global_load_lds((const unsigned*)(bp + (size_t)64 * K + k_ * 32), (ldsp_t)(d_ + 20480), 16, 0, 0); }
#define CMP(BASE) { const unsigned char* sA_ = (BASE); const unsigned char* sB_ = sA_ + 16384;                 \
    bf16x8 wf[4], xf[8];                                                                                        \
    _Pragma("unroll") for (int i = 0; i < 4; ++i) wf[i] = *reinterpret_cast<const bf16x8*>(sB_ + swz32(wn * 64 + i * 16 + c16, g));   \
    _Pragma("unroll") for (int i = 0; i < 8; ++i) xf[i] = *reinterpret_cast<const bf16x8*>(sA_ + swz32(wm * 128 + i * 16 + c16, g));  \
    __builtin_amdgcn_s_setprio(1);                                                                              \
    _Pragma("unroll") for (int mi = 0; mi < 4; ++mi)                                                            \
      _Pragma("unroll") for (int ni = 0; ni < 8; ++ni) acc[mi][ni] = MFMA(wf[mi], xf[ni], acc[mi][ni]);         \
    __builtin_amdgcn_s_setprio(0); }
  if (!pre_issued) { GLD(0, sm) }
  asm volatile("s_waitcnt vmcnt(0)" ::: "memory");
  __syncthreads();
  for (int kt = 0; kt < nk; kt += 2) {
    GLD(kt + 1, sm + 24576)
    CMP(sm)
    asm volatile("s_waitcnt vmcnt(0)" ::: "memory");
    __syncthreads();
    if (kt + 2 < nk) { GLD(kt + 2, sm) }
    CMP(sm + 24576)
    asm volatile("s_waitcnt vmcnt(0)" ::: "memory");
    __syncthreads();
  }
#undef GLD
#undef CMP
  if (ntm >= 0) {
    const bf16_t* nbp = Bt + (size_t)(ntn * 128 + lr) * K + gc;
    const int nrow0 = ntm * 256 + lr;
    unsigned char* d_ = sm + tid * 16;
    __builtin_amdgcn_global_load_lds((const unsigned*)(af.ptr(nrow0, 0) + gc), (ldsp_t)(d_), 16, 0, 0);
    __builtin_amdgcn_global_load_lds((const unsigned*)(af.ptr(nrow0 + 64, 0) + gc), (ldsp_t)(d_ + 4096), 16, 0, 0);
    __builtin_amdgcn_global_load_lds((const unsigned*)(af.ptr(nrow0 + 128, 0) + gc), (ldsp_t)(d_ + 8192), 16, 0, 0);
    __builtin_amdgcn_global_load_lds((const unsigned*)(af.ptr(nrow0 + 192, 0) + gc), (ldsp_t)(d_ + 12288), 16, 0, 0);
    __builtin_amdgcn_global_load_lds((const unsigned*)(nbp), (ldsp_t)(d_ + 16384), 16, 0, 0);
    __builtin_amdgcn_global_load_lds((const unsigned*)(nbp + (size_t)64 * K), (ldsp_t)(d_ + 20480), 16, 0, 0);
  }
#pragma unroll
  for (int hf = 0; hf < 2; ++hf) {
    __builtin_amdgcn_sched_barrier(0);
    f32x4 sub[4][4];
#pragma unroll
    for (int mi = 0; mi < 4; ++mi)
#pragma unroll
      for (int ni = 0; ni < 4; ++ni) sub[mi][ni] = acc[mi][hf * 4 + ni];
    epi(sub, tm * 256 + wm * 128 + hf * 64, tn * 128 + wn * 64, lane);
  }
}

template <class AF, class EPI>
__device__ __forceinline__ void gemm_phase(const AF& af, const bf16_t* Bt, int K, int ntm, int ntn, const EPI& epi, unsigned char* sm) {
  const int total = ntm * ntn;
  bool pre = false;
  for (int i = bidx(); i < total; i += gridDim.x) {
    int x = i & 7, j = i >> 3;
    int grp = j / (8 * ntn), r = j - grp * 8 * ntn;
    int tn = r >> 3, tml = grp * 8 + (r & 7);
    int tm = tml * 8 + x;
    int i2 = i + gridDim.x, ntm2 = -1, ntn2 = -1;
    if (i2 < total) {
      int x2 = i2 & 7, j2 = i2 >> 3;
      int grp2 = j2 / (8 * ntn), r2 = j2 - grp2 * 8 * ntn;
      ntn2 = r2 >> 3; ntm2 = (grp2 * 8 + (r2 & 7)) * 8 + x2;
    }
    gemm_tile(af, Bt, K, tm, tn, epi, sm, pre, ntm2, ntn2);
    pre = (ntm2 >= 0);
  }
}

struct EpiGateUp {
  bf16_t* hid;
  __device__ __forceinline__ void operator()(f32x4 (&acc)[4][4], int tb, int cb, int lane) const {
    const int c16 = lane & 15, g = lane >> 4;
#pragma unroll
    for (int mi = 0; mi < 2; ++mi)
#pragma unroll
      for (int ni = 0; ni < 4; ++ni) {
        float h[4];
#pragma unroll
        for (int j = 0; j < 4; ++j) { float gg = acc[mi][ni][j], uu = acc[mi + 2][ni][j]; h[j] = gg / (1.f + __expf(-gg)) * uu; }
        int f = (cb >> 6) * 32 + mi * 16 + g * 4;
        int tok = tb + ni * 16 + c16;
        *reinterpret_cast<uint2*>(hid + (size_t)tok * FF + f) = pack4(h[0], h[1], h[2], h[3]);
      }
  }
};
struct EpiResid {
  const float* src; float* dst; float alpha;
  __device__ __forceinline__ void operator()(f32x4 (&acc)[4][4], int tb, int cb, int lane) const {
    const int c16 = lane & 15, g = lane >> 4;
#pragma unroll
    for (int mi = 0; mi < 4; ++mi) {
      __builtin_amdgcn_sched_barrier(0);
#pragma unroll
      for (int ni = 0; ni < 4; ++ni) {
        size_t o = (size_t)(tb + ni * 16 + c16) * DM + cb + mi * 16 + g * 4;
        float4 s = *reinterpret_cast<const float4*>(src + o);
        *reinterpret_cast<float4*>(dst + o) = make_float4(s.x + alpha * acc[mi][ni][0], s.y + alpha * acc[mi][ni][1],
                                                          s.z + alpha * acc[mi][ni][2], s.w + alpha * acc[mi][ni][3]);
      }
    }
  }
};
__device__ __forceinline__ void rope_wave(f32x4 (&acc)[4][4], int tb, int lane, const float2* rope, float scale) {
  const int c16 = lane & 15, g = lane >> 4;
#pragma unroll
  for (int ni = 0; ni < 4; ++ni) {
    int t = (tb + ni * 16 + c16) & (T_ - 1);
#pragma unroll
    for (int mi = 0; mi < 2; ++mi)
#pragma unroll
      for (int j = 0; j < 4; ++j) {
        float2 cs = rope[t * 32 + mi * 16 + g * 4 + j];
        float x1 = acc[mi][ni][j], x2 = acc[mi + 2][ni][j];
        acc[mi][ni][j] = (x1 * cs.x - x2 * cs.y) * scale;
        acc[mi + 2][ni][j] = (x2 * cs.x + x1 * cs.y) * scale;
      }
  }
}
__device__ __forceinline__ void store_p(f32x4 (&acc)[4][4], int tb, int cb, int lane, bf16_t* p, int ld) {
  const int c16 = lane & 15, g = lane >> 4;
#pragma unroll
  for (int mi = 0; mi < 4; ++mi)
#pragma unroll
    for (int ni = 0; ni < 4; ++ni)
      *reinterpret_cast<uint2*>(p + (size_t)(tb + ni * 16 + c16) * ld + cb + mi * 16 + g * 4) =
          pack4(acc[mi][ni][0], acc[mi][ni][1], acc[mi][ni][2], acc[mi][ni][3]);
}
__device__ __forceinline__ void store_vt(f32x4 (&acc)[4][4], int tb, int lane, bf16_t* vt, int ebase) {
  const int c16 = lane & 15, g = lane >> 4;
#pragma unroll
  for (int ni = 0; ni < 4; ++ni) {
    int t = (tb + ni * 16 + c16) & (T_ - 1);
#pragma unroll
    for (int mi = 0; mi < 4; ++mi)
#pragma unroll
      for (int j = 0; j < 4; ++j) vt[(size_t)(ebase + mi * 16 + g * 4 + j) * T_ + t] = f2bf(acc[mi][ni][j]);
  }
}
struct EpiWinAB {
  bf16_t* p; bf16_t* vta; const float2* rope;
  __device__ __forceinline__ void operator()(f32x4 (&acc)[4][4], int tb, int cb, int lane) const {
    if (cb < 1024) rope_wave(acc, tb, lane, rope, cb < 512 ? 0.125f * 1.4426950408889634f : 1.f);
    store_p(acc, tb, cb, lane, p, LDAB);
    if (cb >= 1024 && cb < 1536) {
      int b = tb >> 12;
      store_vt(acc, tb, lane, vta + (size_t)b * 512 * T_, cb - 1024);
    }
  }
};
struct EpiWinCD {
  bf16_t* p; bf16_t* vts; bf16_t* vtw; const float2* rope;
  __device__ __forceinline__ void operator()(f32x4 (&acc)[4][4], int tb, int cb, int lane) const {
    if (cb < 512) rope_wave(acc, tb, lane, rope, 0.125f * 1.4426950408889634f);
    else if ((cb >= 768 && cb < 896) || (cb >= 1024 && cb < 1152)) rope_wave(acc, tb, lane, rope, 1.f);
    store_p(acc, tb, cb, lane, p, LDCD);
    int b = tb >> 12;
    if (cb >= 896 && cb < 1024) store_vt(acc, tb, lane, vts + (size_t)b * 128 * T_, cb - 896);
    if (cb >= 1152 && cb < 1280) store_vt(acc, tb, lane, vtw + (size_t)b * 128 * T_, cb - 1152);
  }
};
struct EpiCmp1 {
  bf16_t* hid; const float* bias;
  __device__ __forceinline__ void operator()(f32x4 (&acc)[4][4], int tb, int cb, int lane) const {
    const int c16 = lane & 15, g = lane >> 4;
#pragma unroll
    for (int mi = 0; mi < 4; ++mi) {
      int c = cb + mi * 16 + g * 4;
      float4 bb = *reinterpret_cast<const float4*>(bias + c);
      float bv[4] = {bb.x, bb.y, bb.z, bb.w};
#pragma unroll
      for (int ni = 0; ni < 4; ++ni) {
        float h[4];
#pragma unroll
        for (int j = 0; j < 4; ++j) {
          float x = acc[mi][ni][j] + bv[j];
          float u = 0.7978845608028654f * (x + 0.044715f * x * x * x);
          h[j] = 0.5f * x * (1.f + tanhf(u));
        }
        *reinterpret_cast<uint2*>(hid + (size_t)(tb + ni * 16 + c16) * 256 + c) = pack4(h[0], h[1], h[2], h[3]);
      }
    }
  }
};
__device__ __forceinline__ void phase_cmp2(KP P, const float2* rope) {
  const int tid = tidx(), lane = tid & 63, wid = tid >> 6, c16 = lane & 15, g = lane >> 4;
  for (int task = bidx() * 4 + wid; task < 512; task += gridDim.x * 4) {
    const int kv = task >> 8, R0 = (task & 255) * 16;
    const bf16_t* hid = reinterpret_cast<const bf16_t*>(P->ws + (kv ? OFF_HIDV : OFF_HIDK));
    const bf16_t* w2 = reinterpret_cast<const bf16_t*>(P->ws + (kv ? OFF_W2V : OFF_W2K));
    f32x4 acc[4];
#pragma unroll
    for (int mi = 0; mi < 4; ++mi) acc[mi] = f32x4{0.f, 0.f, 0.f, 0.f};
#pragma unroll
    for (int ks = 0; ks < 8; ++ks) {
      bf16x8 xf = u4frag(*reinterpret_cast<const uint4*>(hid + (size_t)(R0 + c16) * 256 + ks * 32 + g * 8));
#pragma unroll
      for (int mi = 0; mi < 4; ++mi) {
        bf16x8 wf = u4frag(*reinterpret_cast<const uint4*>(w2 + (size_t)(mi * 16 + c16) * 256 + ks * 32 + g * 8));
        acc[mi] = MFMA(wf, xf, acc[mi]);
      }
    }
    const int R = R0 + c16, bg = R >> 8, n = R & 255;
    if (kv == 0) {
      bf16_t* dst = reinterpret_cast<bf16_t*>(P->ws + OFF_KCMP);
      int pos = min(16 * n + 31, T_ - 1);
#pragma unroll
      for (int mi = 0; mi < 2; ++mi)
#pragma unroll
        for (int j = 0; j < 4; ++j) {
          float2 cs = rope[pos * 32 + mi * 16 + g * 4 + j];
          float x1 = acc[mi][j], x2 = acc[mi + 2][j];
          acc[mi][j] = x1 * cs.x - x2 * cs.y;
          acc[mi + 2][j] = x2 * cs.x + x1 * cs.y;
        }
#pragma unroll
      for (int mi = 0; mi < 4; ++mi)
        *reinterpret_cast<uint2*>(dst + ((size_t)bg * 256 + n) * 64 + mi * 16 + g * 4) = pack4(acc[mi][0], acc[mi][1], acc[mi][2], acc[mi][3]);
    } else {
      bf16_t* dst = reinterpret_cast<bf16_t*>(P->ws + OFF_VCMPT);
#pragma unroll
      for (int mi = 0; mi < 4; ++mi)
#pragma unroll
        for (int j = 0; j < 4; ++j) dst[((size_t)bg * 64 + mi * 16 + g * 4 + j) * 256 + n] = f2bf(acc[mi][j]);
    }
  }
}

template <int EM, class MaskF>
__device__ __forceinline__ void flash_tile(f32x4 (&O)[EM][2], float (&m)[2], float (&l)[2], const bf16x8 (&qf)[2][2],
                                           const unsigned char* Ks, const unsigned char* Vs, bool domask, bool first, int lane,
                                           const MaskF& valid) {
  const int c16 = lane & 15, g = lane >> 4;
  f32x4 S[4][2];
#pragma unroll
  for (int mi = 0; mi < 4; ++mi) {
    S[mi][0] = f32x4{-m[0], -m[0], -m[0], -m[0]}; S[mi][1] = f32x4{-m[1], -m[1], -m[1], -m[1]};
#pragma unroll
    for (int ks = 0; ks < 2; ++ks) {
      bf16x8 kf = ldsfrag(Ks, mi * 16 + c16, ks * 4 + g);
      S[mi][0] = MFMA(kf, qf[0][ks], S[mi][0]);
      S[mi][1] = MFMA(kf, qf[1][ks], S[mi][1]);
    }
  }
  if (domask) {
#pragma unroll
    for (int mi = 0; mi < 4; ++mi)
#pragma unroll
      for (int ni = 0; ni < 2; ++ni)
#pragma unroll
        for (int j = 0; j < 4; ++j)
          if (!valid(mi * 16 + g * 4 + j, ni)) S[mi][ni][j] = -1e30f;
  }
  float mx[2];
#pragma unroll
  for (int ni = 0; ni < 2; ++ni) {
    float v = -1e30f;
#pragma unroll
    for (int mi = 0; mi < 4; ++mi)
#pragma unroll
      for (int j = 0; j < 4; ++j) v = fmaxf(v, S[mi][ni][j]);
    mx[ni] = v;
  }
  if (__any(first || mx[0] > 8.f || mx[1] > 8.f)) {
#pragma unroll
    for (int ni = 0; ni < 2; ++ni) {
      float v = mx[ni];
      v = fmaxf(v, __shfl_xor(v, 16));
      v = fmaxf(v, __shfl_xor(v, 32));
      float delta = (v > -1e29f) ? (first ? v : fmaxf(v, 0.f)) : 0.f;
      float al = ex2(-delta);
      m[ni] += delta;
      l[ni] *= al;
#pragma unroll
      for (int me = 0; me < EM; ++me) { O[me][ni][0] *= al; O[me][ni][1] *= al; O[me][ni][2] *= al; O[me][ni][3] *= al; }
#pragma unroll
      for (int mi = 0; mi < 4; ++mi) { S[mi][ni][0] -= delta; S[mi][ni][1] -= delta; S[mi][ni][2] -= delta; S[mi][ni][3] -= delta; }
    }
  }
#pragma unroll
  for (int ni = 0; ni < 2; ++ni) {
    float rs = 0.f;
#pragma unroll
    for (int mi = 0; mi < 4; ++mi)
#pragma unroll
      for (int j = 0; j < 4; ++j) {
        float pv = ex2(S[mi][ni][j]);
        S[mi][ni][j] = pv; rs += pv;
      }
    l[ni] += rs;
  }
  bf16x8 pf[2][2];
#pragma unroll
  for (int ni = 0; ni < 2; ++ni) { pf[ni][0] = packfrag(S[0][ni], S[1][ni]); pf[ni][1] = packfrag(S[2][ni], S[3][ni]); }
#pragma unroll
  for (int me = 0; me < EM; ++me)
#pragma unroll
    for (int s = 0; s < 2; ++s) {
      bf16x8 vf = ldsfragP(Vs, me * 16 + c16, s, g);
      O[me][0] = MFMA(vf, pf[0][s], O[me][0]);
      O[me][1] = MFMA(vf, pf[1][s], O[me][1]);
    }
}

__device__ __forceinline__ void load_tile(unsigned char* dst, const bf16_t* src, size_t ld, int rows) {
  for (int i = tidx(); i < rows * 8; i += NTHR) {
    int r = i >> 3, c = i & 7;
    *reinterpret_cast<uint4*>(dst + swz(r, c)) = *reinterpret_cast<const uint4*>(src + (size_t)r * ld + c * 8);
  }
}


__device__ __forceinline__ void load_tile_dma(unsigned char* dst, const bf16_t* src, size_t ld, int rows) {
  typedef __attribute__((address_space(3))) unsigned* ldsp_t;
  const int tid = tidx();
  for (int i = tid; i < rows * 8; i += NTHR) {
    int r = i >> 3, c = (i & 7) ^ (r & 7);
    __builtin_amdgcn_global_load_lds((const unsigned*)(src + (size_t)r * ld + c * 8), (ldsp_t)(dst + i * 16), 16, 0, 0);
  }
}

__device__ __forceinline__ void diffattn_item(KP P, int item, unsigned char* sm) {
  const int tid = tidx(), lane = tid & 63, wid = tid >> 6, c16 = lane & 15, g = lane >> 4;
  const int qb = 63 - (item >> 5);
  const int bh = item & 31, b = bh >> 2, h = bh & 3;
  const int comp = wid >> 1, qh = wid & 1;
  const bf16_t* p = reinterpret_cast<const bf16_t*>(P->ws + OFF_B) + (size_t)b * T_ * LDAB;
  const bf16_t* vt = reinterpret_cast<const bf16_t*>(P->ws + OFF_C) + (size_t)(b * 4 + h) * 128 * T_;
  bf16_t* mix = reinterpret_cast<bf16_t*>(P->ws + OFF_A);
  const int t0 = qb * 64, tq0 = t0 + qh * 32;
  bf16x8 qf[2][2];
#pragma unroll
  for (int ni = 0; ni < 2; ++ni)
#pragma unroll
    for (int ks = 0; ks < 2; ++ks)
      qf[ni][ks] = u4frag(*reinterpret_cast<const uint4*>(p + (size_t)(tq0 + ni * 16 + c16) * LDAB + h * 128 + comp * 64 + (ks * 4 + g) * 8));
  f32x4 O[8][2];
#pragma unroll
  for (int i = 0; i < 8; ++i) { O[i][0] = f32x4{0.f, 0.f, 0.f, 0.f}; O[i][1] = f32x4{0.f, 0.f, 0.f, 0.f}; }
  float m[2] = {0.f, 0.f}, l[2] = {0.f, 0.f};
  __syncthreads();
  load_tile_dma(sm, p + 512 + h * 128, LDAB, 64);
  load_tile_dma(sm + 8192, p + 512 + h * 128 + 64, LDAB, 64);
  load_tile_dma(sm + 16384, vt, T_, 128);
  asm volatile("s_waitcnt vmcnt(0)" ::: "memory");
  __syncthreads();
  for (int kt = 0; kt <= qb; ++kt) {
    unsigned char* cur = sm + (kt & 1) * 32768;
    if (kt < qb) {
      unsigned char* nxt = sm + ((kt + 1) & 1) * 32768;
      load_tile_dma(nxt, p + (size_t)((kt + 1) * 64) * LDAB + 512 + h * 128, LDAB, 64);
      load_tile_dma(nxt + 8192, p + (size_t)((kt + 1) * 64) * LDAB + 512 + h * 128 + 64, LDAB, 64);
      load_tile_dma(nxt + 16384, vt + (kt + 1) * 64, T_, 128);
    }
    const int kbase = kt * 64;
    flash_tile<8>(O, m, l, qf, cur + (comp ? 8192 : 0), cur + 16384, kt == qb, kt == 0, lane,
                  [&](int key, int ni) { return kbase + key <= tq0 + ni * 16 + c16; });
    asm volatile("s_waitcnt vmcnt(0)" ::: "memory");
    __syncthreads();
  }
#pragma unroll
  for (int ni = 0; ni < 2; ++ni) { l[ni] += __shfl_xor(l[ni], 16); l[ni] += __shfl_xor(l[ni], 32); }
  __syncthreads();
  float* X = reinterpret_cast<float*>(sm);
  const float lam = reinterpret_cast<const float*>(P->ws + OFF_MISC)[0];
  if (comp == 1) {
#pragma unroll
    for (int ni = 0; ni < 2; ++ni) {
      float sc = lam / l[ni];
#pragma unroll
      for (int me = 0; me < 8; ++me)
#pragma unroll
        for (int j = 0; j < 4; ++j) X[(me * 16 + g * 4 + j) * 64 + qh * 32 + ni * 16 + c16] = O[me][ni][j] * sc;
    }
  }
  __syncthreads();
  if (comp == 0) {
    const float* subln = P->in[13];
#pragma unroll
    for (int ni = 0; ni < 2; ++ni) {
      float il = 1.f / l[ni], ss = 0.f;
#pragma unroll
      for (int me = 0; me < 8; ++me)
#pragma unroll
        for (int j = 0; j < 4; ++j) {
          float v = O[me][ni][j] * il - X[(me * 16 + g * 4 + j) * 64 + qh * 32 + ni * 16 + c16];
          O[me][ni][j] = v; ss += v * v;
        }
      ss += __shfl_xor(ss, 16); ss += __shfl_xor(ss, 32);
      float r = rsqrtf(ss * (1.f / 128.f) + 1e-6f) * 0.8f;
      size_t row = (size_t)(b * T_ + tq0 + ni * 16 + c16) * DM + h * 128;
#pragma unroll
      for (int me = 0; me < 8; ++me) {
        int e = me * 16 + g * 4;
        float4 w = *reinterpret_cast<const float4*>(subln + e);
        *reinterpret_cast<uint2*>(mix + row + e) =
            pack4(O[me][ni][0] * r * w.x, O[me][ni][1] * r * w.y, O[me][ni][2] * r * w.z, O[me][ni][3] * r * w.w);
      }
    }
  }
  __syncthreads();
}

__device__ __forceinline__ float red8(float x) { x = red4(x); x += dppf<0x141>(x); return x; }

template <int MODE>
__device__ __forceinline__ void rwkv_work(KP P, int chain, int half, int tbeg, int tend, unsigned char* sm) {
  constexpr int CH = 32;
  constexpr int NIT = (MODE == 0) ? 5 : 7;
  const int tid = tidx(), lane = tid & 63, wid = tid >> 6, c16 = lane & 15, g = lane >> 4;
  const int b = chain >> 3, h = chain & 7;
  const bf16_t* p = reinterpret_cast<const bf16_t*>(P->ws + OFF_B) + (size_t)b * T_ * LDAB;
  bf16_t* mix = reinterpret_cast<bf16_t*>(P->ws + OFF_A);
  float* ybuf = reinterpret_cast<float*>(P->ws + OFF_Y);
  float* xr = reinterpret_cast<float*>(sm);
  float* xk = xr + CH * 64;
  float* xv = xk + CH * 64;
  float* dec = xv + CH * 64;
  float* av = (MODE == 0) ? dec + CH * 64 : xv + CH * 64;
  float* kkv = av + CH * 64;
  float* gv = av + CH * 64;
  unsigned char* twl = sm + 49152;
  unsigned char* xal = (MODE == 0) ? sm + 53248 : sm + 40960;
  unsigned char* sgl = sm + 45056;
  float* mus = reinterpret_cast<float*>(sm + 57344);
  float* bonus = mus + 448;
  float* cst = bonus + CH;
  float* sc2 = cst + 448;
  for (int i = tid; i < 448; i += NTHR) {
    int a = i >> 6, n = h * 64 + (i & 63);
    const float* src = (a == 0) ? P->in[15] : (a == 1) ? P->in[17] : (a == 2) ? P->in[20] : (a == 3) ? P->in[21] : (a == 4) ? P->in[22] : (a == 5) ? P->in[23] : P->in[24];
    cst[i] = src[n];
  }
  for (int i = tid; i < 448; i += NTHR) {
    int ch = i >> 3, e = i & 7;
    int col = (ch < 24) ? ((ch >> 3) * 512 + h * 64 + (ch & 7) * 8) : (1536 + (ch - 24) * 8);
    mus[i] = P->in[14][col + e];
  }
  bf16x8 w2f[2], a2f[2], g2f[4];
  {
    const float* w2 = P->in[16]; const float* a2 = P->in[18]; const float* g2 = P->in[19];
    int n = h * 64 + wid * 16 + c16;
#pragma unroll
    for (int ks = 0; ks < 2; ++ks)
#pragma unroll
      for (int jj = 0; jj < 8; ++jj) {
        int k = ks * 32 + g * 8 + jj;
        if (MODE == 0) w2f[ks][jj] = (short)f2bf(w2[k * 512 + n]);
        a2f[ks][jj] = (short)f2bf(a2[k * 512 + n]);
      }
    if (MODE == 1) {
#pragma unroll
      for (int ks = 0; ks < 4; ++ks)
#pragma unroll
        for (int jj = 0; jj < 8; ++jj) g2f[ks][jj] = (short)f2bf(g2[(ks * 32 + g * 8 + jj) * 512 + n]);
    }
  }
  const int tokc = tid >> 4, colc = (tid & 15) * 4;
  const int vrow = half * 16 + (tid >> 4), kq = tid & 15;
  f32x2 S2[2];
#pragma unroll
  for (int i = 0; i < 2; ++i) S2[i] = f32x2{0.f, 0.f};
  __syncthreads();
  const int wuu = __builtin_amdgcn_readfirstlane(wid);
  uint4 rcu[NIT], rpu[NIT];
  auto item_of = [&](int it, int& tok, int& ch) -> int {
    int sl = it * 4 + wuu;
    if (MODE == 1 && sl >= 12) sl += 4;
    if (sl < 12) { int j = sl * 64 + lane; tok = j / 24; ch = j - tok * 24; return 0; }
    if (sl < 16) { int j = (sl - 12) * 64 + lane; tok = j >> 3; ch = 24 + (j & 7); return 1; }
    if (sl < 20) { int j = (sl - 16) * 64 + lane; tok = j >> 3; ch = 32 + (j & 7); return 2; }
    if (MODE == 1 && sl < 28) { int j = (sl - 20) * 64 + lane; tok = j >> 4; ch = 40 + (j & 15); return 3; }
    tok = 0; ch = 0; return -1;
  };
  auto issue_a = [&](int t0n) {
#pragma unroll
    for (int it = 0; it < NIT; ++it) {
      int tok, ch;
      int ty = item_of(it, tok, ch);
      rcu[it] = make_uint4(0, 0, 0, 0); rpu[it] = make_uint4(0, 0, 0, 0);
      if (ty >= 0) {
        int col = 1536 + ((ch < 24) ? ((ch >> 3) * 512 + h * 64 + (ch & 7) * 8) : (1536 + (ch - 24) * 8));
        int t = t0n + tok;
        rcu[it] = *reinterpret_cast<const uint4*>(p + (size_t)t * LDAB + col);
        if (t > 0) rpu[it] = *reinterpret_cast<const uint4*>(p + (size_t)(t - 1) * LDAB + col);
      }
    }
  };
  issue_a(tbeg);
  for (int t0 = tbeg; t0 < tend; t0 += CH) {
#pragma unroll
    for (int it = 0; it < NIT; ++it) {
      int tok, ch;
      int ty = item_of(it, tok, ch);
      if (ty >= 0) {
        uint4 cu = rcu[it], pu = rpu[it];
        const unsigned cw[4] = {cu.x, cu.y, cu.z, cu.w}, pw[4] = {pu.x, pu.y, pu.z, pu.w};
        float xm[8];
#pragma unroll
        for (int e = 0; e < 8; ++e) {
          float c = bf2f((unsigned short)(cw[e >> 1] >> ((e & 1) * 16)));
          float q = bf2f((unsigned short)(pw[e >> 1] >> ((e & 1) * 16)));
          xm[e] = c + (q - c) * mus[ch * 8 + e];
        }
        if (ty == 0) {
          float* d = xr + (ch >> 3) * (CH * 64) + tok * 64 + (ch & 7) * 8;
          *reinterpret_cast<float4*>(d) = make_float4(xm[0], xm[1], xm[2], xm[3]);
          *reinterpret_cast<float4*>(d + 4) = make_float4(xm[4], xm[5], xm[6], xm[7]);
        } else {
          unsigned char* d;
          if (ty == 1) { d = twl + swz(tok, ch - 24);
#pragma unroll
            for (int e = 0; e < 8; ++e) xm[e] = ftanhf_(xm[e]); }
          else if (ty == 2) d = xal + swz(tok, ch - 32);
          else { d = sgl + ((ch - 40) >> 3) * 4096 + swz(tok, (ch - 40) & 7);
#pragma unroll
            for (int e = 0; e < 8; ++e) xm[e] = sigmoidf_(xm[e]); }
          *reinterpret_cast<uint4*>(d) = make_uint4(pack2(xm[0], xm[1]), pack2(xm[2], xm[3]), pack2(xm[4], xm[5]), pack2(xm[6], xm[7]));
        }
      }
    }
    if (t0 + CH < tend) issue_a(t0 + CH);
    __syncthreads();
#pragma unroll
    for (int nt = 0; nt < 2; ++nt) {
      f32x4 aw = {0.f, 0.f, 0.f, 0.f}, aa = {0.f, 0.f, 0.f, 0.f}, ag = {0.f, 0.f, 0.f, 0.f};
#pragma unroll
      for (int ks = 0; ks < 2; ++ks) {
        if (MODE == 0) aw = MFMA(w2f[ks], ldsfrag(twl, nt * 16 + c16, ks * 4 + g), aw);
        aa = MFMA(a2f[ks], ldsfrag(xal, nt * 16 + c16, ks * 4 + g), aa);
      }
      if (MODE == 1) {
#pragma unroll
        for (int ks = 0; ks < 4; ++ks) ag = MFMA(g2f[ks], ldsfrag(sgl + (ks >> 1) * 4096, nt * 16 + c16, (ks & 1) * 4 + g), ag);
      }
      float dv[4], a4[4];
      const float4 w04 = *reinterpret_cast<const float4*>(cst + wid * 16 + g * 4);
      const float4 a04 = *reinterpret_cast<const float4*>(cst + 64 + wid * 16 + g * 4);
      const float w0c[4] = {w04.x, w04.y, w04.z, w04.w}, a0c[4] = {a04.x, a04.y, a04.z, a04.w};
#pragma unroll
      for (int j = 0; j < 4; ++j) {
        if (MODE == 0) {
          float wv = w0c[j] + aw[j];
          float w = -__logf(1.f + __expf(-wv)) - 0.5f;
          dv[j] = __expf(-__expf(w));
        }
        a4[j] = sigmoidf_(a0c[j] + aa[j]);
      }
      int o = (nt * 16 + c16) * 64 + wid * 16 + g * 4;
      if (MODE == 0) *reinterpret_cast<float4*>(dec + o) = make_float4(dv[0], dv[1], dv[2], dv[3]);
      *reinterpret_cast<float4*>(av + o) = make_float4(a4[0], a4[1], a4[2], a4[3]);
      if (MODE == 1) *reinterpret_cast<float4*>(gv + o) = make_float4(ag[0], ag[1], ag[2], ag[3]);
    }
    __syncthreads();
#pragma unroll
    for (int tt = 0; tt < 2; ++tt) {
      const int tk = tokc + tt * 16;
      int o = tk * 64 + colc;
      float4 k4 = *reinterpret_cast<float4*>(xk + o), a4 = *reinterpret_cast<float4*>(av + o), r4 = *reinterpret_cast<float4*>(xr + o);
      float k[4] = {k4.x, k4.y, k4.z, k4.w}, a[4] = {a4.x, a4.y, a4.z, a4.w}, r[4] = {r4.x, r4.y, r4.z, r4.w};
      const float4 c0 = *reinterpret_cast<const float4*>(cst + 128 + colc);
      const float4 c1 = *reinterpret_cast<const float4*>(cst + 192 + colc);
      const float4 c2 = *reinterpret_cast<const float4*>(cst + 256 + colc);
      const float kkc[4] = {c0.x, c0.y, c0.z, c0.w}, kac[4] = {c1.x, c1.y, c1.z, c1.w}, rkc[4] = {c2.x, c2.y, c2.z, c2.w};
      float kk[4], kp[4], ss = 0.f, bs = 0.f;
#pragma unroll
      for (int i = 0; i < 4; ++i) {
        kk[i] = k[i] * kkc[i]; ss += kk[i] * kk[i];
        kp[i] = k[i] * (1.f + (a[i] - 1.f) * kac[i]);
        bs += r[i] * kp[i] * rkc[i];
      }
      if (MODE == 1) {
        bs = red16(bs);
        if ((tid & 15) == 0) bonus[tk] = bs;
      } else {
        ss = red16(ss);
        float rn = rsqrtf(ss + 1e-12f);
        float4 d4 = *reinterpret_cast<float4*>(dec + o);
        const float dd[4] = {d4.x, d4.y, d4.z, d4.w};
        float brs = 0.f, krs = 0.f, bv4[4];
#pragma unroll
        for (int i = 0; i < 4; ++i) { kk[i] *= rn; bv4[i] = kk[i] * a[i]; brs += bv4[i] * r[i]; krs += kp[i] * r[i]; }
        brs = red16(brs); krs = red16(krs);
        *reinterpret_cast<float4*>(kkv + o) = make_float4(kk[0], kk[1], kk[2], kk[3]);
        *reinterpret_cast<float4*>(av + o) = make_float4(bv4[0], bv4[1], bv4[2], bv4[3]);
        *reinterpret_cast<float4*>(xk + o) = make_float4(kp[0], kp[1], kp[2], kp[3]);
        *reinterpret_cast<float4*>(xr + o) = make_float4(dd[0] * r[0], dd[1] * r[1], dd[2] * r[2], dd[3] * r[3]);
        if ((tid & 15) == 0) { sc2[tk * 2] = brs; sc2[tk * 2 + 1] = krs; }
      }
    }
    __syncthreads();
    if (MODE == 0) {
      const int ko = kq * 4;
      f32x2 K2[2], W2[2], D2[2], P2[2], B2[2];
#define LD4(DST, SRC) { float4 t4 = *reinterpret_cast<const float4*>(SRC); DST[0] = f32x2{t4.x, t4.y}; DST[1] = f32x2{t4.z, t4.w}; }
      LD4(K2, kkv + ko) LD4(W2, xr + ko) LD4(D2, dec + ko) LD4(P2, xk + ko) LD4(B2, av + ko)
      float vv = xv[vrow];
      const float2 scl = *reinterpret_cast<const float2*>(sc2 + (lane & (CH - 1)) * 2);
      float* yout = ybuf + (size_t)(b * T_ + t0) * 512 + h * 64 + vrow;
#pragma unroll 2
      for (int t = 0; t < CH; ++t) {
        const int tn1 = (t < CH - 1 ? t + 1 : CH - 1);
        const int tn = tn1 * 64 + ko;
        float vvn = xv[tn1 * 64 + vrow];
        f32x2 sa2 = S2[0] * K2[0] + S2[1] * K2[1];
        f32x2 ya2 = S2[0] * W2[0] + S2[1] * W2[1];
        LD4(K2, kkv + tn) LD4(W2, xr + tn)
        const f32x2 vv2 = f32x2{vv, vv};
        f32x2 tmp0 = S2[0] * D2[0] + vv2 * P2[0], tmp1 = S2[1] * D2[1] + vv2 * P2[1];
        float sa = red16(sa2[0] + sa2[1]);
        float ya = red16(ya2[0] + ya2[1]);
        const f32x2 nsa2 = f32x2{-sa, -sa};
        S2[0] = tmp0 + nsa2 * B2[0]; S2[1] = tmp1 + nsa2 * B2[1];
        const float brs = __int_as_float(__builtin_amdgcn_readlane(__float_as_int(scl.x), t));
        const float krs = __int_as_float(__builtin_amdgcn_readlane(__float_as_int(scl.y), t));
        float y = ya - sa * brs + vv * krs;
        asm volatile("" : "+v"(y));
        if (kq == 0) yout[(size_t)t * 512] = y;
        LD4(D2, dec + tn) LD4(P2, xk + tn) LD4(B2, av + tn)
        asm volatile("" : "+v"(vvn));
        vv = vvn;
      }
#undef LD4
    } else {
#pragma unroll
      for (int tt = 0; tt < 2; ++tt) {
        const int tk = tokc + tt * 16;
        int o = tk * 64 + colc;
        float4 y4 = *reinterpret_cast<const float4*>(ybuf + (size_t)(b * T_ + t0 + tk) * 512 + h * 64 + colc);
        float4 v4 = *reinterpret_cast<float4*>(xv + o), g4 = *reinterpret_cast<float4*>(gv + o);
        float y[4] = {y4.x, y4.y, y4.z, y4.w}, v[4] = {v4.x, v4.y, v4.z, v4.w}, gg[4] = {g4.x, g4.y, g4.z, g4.w};
        const float4 c3 = *reinterpret_cast<const float4*>(cst + 320 + colc);
        const float4 c4 = *reinterpret_cast<const float4*>(cst + 384 + colc);
        const float lnw[4] = {c3.x, c3.y, c3.z, c3.w}, lnb[4] = {c4.x, c4.y, c4.z, c4.w};
        float s = red16(y[0] + y[1] + y[2] + y[3]);
        float mean = s * (1.f / 64.f), vs = 0.f;
#pragma unroll
        for (int i = 0; i < 4; ++i) { y[i] -= mean; vs += y[i] * y[i]; }
        vs = red16(vs);
        float rs = rsqrtf(vs * (1.f / 64.f) + 64e-5f), bn = bonus[tk];
        float ov[4];
#pragma unroll
        for (int i = 0; i < 4; ++i) ov[i] = (y[i] * rs * lnw[i] + lnb[i] + bn * v[i]) * gg[i];
        *reinterpret_cast<uint2*>(mix + (size_t)(b * T_ + t0 + tk) * DM + 512 + h * 64 + colc) = pack4(ov[0], ov[1], ov[2], ov[3]);
      }
    }
    __syncthreads();
  }
}

__device__ __forceinline__ void phase_mixAB(KP P, unsigned char* sm) {
  volatile int& s_item = *reinterpret_cast<volatile int*>(sm + 65532);
  if (bidx() < 256) rwkv_work<0>(P, bidx() >> 2, bidx() & 3, 0, T_, sm);
  unsigned* cnt = reinterpret_cast<unsigned*>(P->ws + OFF_MISC + 64);
  for (;;) {
    __syncthreads();
    if (tidx() == 0) s_item = (int)atomicAdd(cnt, 1u);
    __syncthreads();
    int item = s_item;
    if (item >= 2048) break;
    diffattn_item(P, item, sm);
  }
  unsigned* cnt2 = reinterpret_cast<unsigned*>(P->ws + OFF_MISC + 72);
  for (;;) {
    __syncthreads();
    if (tidx() == 0) s_item = (int)atomicAdd(cnt2, 1u);
    __syncthreads();
    int v = s_item;
    if (v >= TR_TOTAL - TR_EARLY) break;
    transpose_tile(P, tr_late_tile(v), sm);
  }
}

__device__ __forceinline__ void nsa_item(KP P, int item, unsigned char* sm) {
  const int tid = tidx(), lane = tid & 63, wid = tid >> 6, c16 = lane & 15, g = lane >> 4;
  const int qblk = 127 - (item >> 4);
  const int bg = item & 15, b = bg >> 1, gg = bg & 1;
  const int t0 = qblk * 32;
  const bf16_t* p = reinterpret_cast<const bf16_t*>(P->ws + OFF_B) + (size_t)b * T_ * LDCD;
  const bf16_t* kcmp = reinterpret_cast<const bf16_t*>(P->ws + OFF_KCMP) + (size_t)bg * 256 * 64;
  const bf16_t* vcmpT = reinterpret_cast<const bf16_t*>(P->ws + OFF_VCMPT) + (size_t)bg * 64 * 256;
  const bf16_t* vts = reinterpret_cast<const bf16_t*>(P->ws + OFF_VTS) + (size_t)bg * 64 * T_;
  const bf16_t* vtw = reinterpret_cast<const bf16_t*>(P->ws + OFF_VTW) + (size_t)bg * 64 * T_;
  bf16_t* mix = reinterpret_cast<bf16_t*>(P->ws + OFF_A);
  unsigned char* Ks = sm; unsigned char* Vs = sm + 8192;
  float* psum = reinterpret_cast<float*>(sm + 16384);
  unsigned long long* selm = reinterpret_cast<unsigned long long*>(sm + 16384 + 32768);
  unsigned long long* selu = selm + 32;
  const int hh = c16 & 3;
  int tq[2];
  bf16x8 qf[2][2];
#pragma unroll
  for (int ni = 0; ni < 2; ++ni) {
    tq[ni] = t0 + wid * 8 + ni * 4 + (c16 >> 2);
#pragma unroll
    for (int ks = 0; ks < 2; ++ks)
      qf[ni][ks] = u4frag(*reinterpret_cast<const uint4*>(p + (size_t)tq[ni] * LDCD + (gg * 4 + hh) * 64 + (ks * 4 + g) * 8));
  }
  float gate[2][3];
#pragma unroll
  for (int ni = 0; ni < 2; ++ni)
#pragma unroll
    for (int br = 0; br < 3; ++br) gate[ni][br] = sigmoidf_(bf2f(p[(size_t)tq[ni] * LDCD + 1280 + (gg * 4 + hh) * 3 + br]));
  f32x4 O[4][2];
  float m[2], l[2];
  const int ncv = min(255, t0 / 16 + 1);
  const int nct = (ncv + 63) >> 6;
  for (int i = tid; i < 32 * 256; i += NTHR) psum[i] = 0.f;
  m[0] = m[1] = -1e30f; l[0] = l[1] = 0.f;
  for (int ct = 0; ct < nct; ++ct) {
    __syncthreads();
    load_tile(Ks, kcmp + (size_t)ct * 64 * 64, 64, 64);
    __syncthreads();
    f32x4 S[4][2];
#pragma unroll
    for (int mi = 0; mi < 4; ++mi) {
      S[mi][0] = f32x4{0.f, 0.f, 0.f, 0.f}; S[mi][1] = f32x4{0.f, 0.f, 0.f, 0.f};
#pragma unroll
      for (int ks = 0; ks < 2; ++ks) {
        bf16x8 kf = ldsfrag(Ks, mi * 16 + c16, ks * 4 + g);
        S[mi][0] = MFMA(kf, qf[0][ks], S[mi][0]);
        S[mi][1] = MFMA(kf, qf[1][ks], S[mi][1]);
      }
    }
#pragma unroll
    for (int ni = 0; ni < 2; ++ni) {
      float mx = -1e30f;
#pragma unroll
      for (int mi = 0; mi < 4; ++mi)
#pragma unroll
        for (int j = 0; j < 4; ++j) {
          int n = ct * 64 + mi * 16 + g * 4 + j;
          bool ok = (n < 255) && (16 * n + 31 <= tq[ni]);
          if (!ok) S[mi][ni][j] = -1e30f;
          mx = fmaxf(mx, S[mi][ni][j]);
        }
      mx = fmaxf(mx, __shfl_xor(mx, 16)); mx = fmaxf(mx, __shfl_xor(mx, 32));
      float mn = fmaxf(m[ni], mx);
      float rs = 0.f;
#pragma unroll
      for (int mi = 0; mi < 4; ++mi)
#pragma unroll
        for (int j = 0; j < 4; ++j) { float s = S[mi][ni][j]; rs += (s > -1e29f) ? ex2(s - mn) : 0.f; }
      l[ni] = l[ni] * ex2(m[ni] - mn) + rs;
      m[ni] = mn;
    }
  }
  float il[2];
#pragma unroll
  for (int ni = 0; ni < 2; ++ni) {
    l[ni] += __shfl_xor(l[ni], 16); l[ni] += __shfl_xor(l[ni], 32);
    il[ni] = (l[ni] > 0.f) ? 1.f / l[ni] : 0.f;
  }
#pragma unroll
  for (int i = 0; i < 4; ++i) { O[i][0] = f32x4{0.f, 0.f, 0.f, 0.f}; O[i][1] = f32x4{0.f, 0.f, 0.f, 0.f}; }
  for (int ct = 0; ct < nct; ++ct) {
    __syncthreads();
    load_tile(Ks, kcmp + (size_t)ct * 64 * 64, 64, 64);
    load_tile(Vs, vcmpT + ct * 64, 256, 64);
    __syncthreads();
    f32x4 S[4][2];
#pragma unroll
    for (int mi = 0; mi < 4; ++mi) {
      S[mi][0] = f32x4{0.f, 0.f, 0.f, 0.f}; S[mi][1] = f32x4{0.f, 0.f, 0.f, 0.f};
#pragma unroll
      for (int ks = 0; ks < 2; ++ks) {
        bf16x8 kf = ldsfrag(Ks, mi * 16 + c16, ks * 4 + g);
        S[mi][0] = MFMA(kf, qf[0][ks], S[mi][0]);
        S[mi][1] = MFMA(kf, qf[1][ks], S[mi][1]);
      }
    }
#pragma unroll
    for (int ni = 0; ni < 2; ++ni)
#pragma unroll
      for (int mi = 0; mi < 4; ++mi)
#pragma unroll
        for (int j = 0; j < 4; ++j) {
          int n = ct * 64 + mi * 16 + g * 4 + j;
          bool ok = (n < 255) && (16 * n + 31 <= tq[ni]);
          float pv = ok ? ex2(S[mi][ni][j] - m[ni]) * il[ni] : 0.f;
          S[mi][ni][j] = pv;
          float hs = red4(pv);
          if (hh == 0) psum[(wid * 8 + ni * 4 + (c16 >> 2)) * 256 + n] = hs;
        }
    bf16x8 pf[2][2];
#pragma unroll
    for (int ni = 0; ni < 2; ++ni) { pf[ni][0] = packfrag(S[0][ni], S[1][ni]); pf[ni][1] = packfrag(S[2][ni], S[3][ni]); }
#pragma unroll
    for (int me = 0; me < 4; ++me)
#pragma unroll
      for (int s = 0; s < 2; ++s) {
        bf16x8 vf = ldsfragP(Vs, me * 16 + c16, s, g);
        O[me][0] = MFMA(vf, pf[0][s], O[me][0]);
        O[me][1] = MFMA(vf, pf[1][s], O[me][1]);
      }
  }
#pragma unroll
  for (int ni = 0; ni < 2; ++ni)
#pragma unroll
    for (int me = 0; me < 4; ++me)
#pragma unroll
      for (int j = 0; j < 4; ++j) O[me][ni][j] *= gate[ni][0];
  __syncthreads();
  {
    unsigned long long un = 0ull;
    float* scw = reinterpret_cast<float*>(selu + 4) + wid * 64;
#pragma unroll 1
    for (int qi = 0; qi < 8; ++qi) {
      int q = wid * 8 + qi, t = t0 + q, j = lane;
      float4 a = *reinterpret_cast<const float4*>(psum + q * 256 + 4 * j);
      float imp = a.x + a.y + a.z + 0.5f * a.w;
      if (j > 0) imp += 0.5f * psum[q * 256 + 4 * j - 1];
      int cur = t >> 6;
      bool forced = (j == 0) || (j == cur) || (j == cur - 1);
      bool vld = (j * 64 <= t);
      float score = vld ? (imp + (forced ? 1e4f : 0.f)) : -1e30f;
      int rank = 0;
      scw[lane] = score;
      __builtin_amdgcn_fence(__ATOMIC_RELEASE, "wavefront");
      __builtin_amdgcn_wave_barrier();
      __builtin_amdgcn_fence(__ATOMIC_ACQUIRE, "wavefront");
#pragma unroll 4
      for (int i4 = 0; i4 < 16; ++i4) {
        float4 o = *reinterpret_cast<const float4*>(scw + i4 * 4);
        int i = i4 * 4;
        rank += (o.x > score || (o.x == score && i < j)) ? 1 : 0;
        rank += (o.y > score || (o.y == score && i + 1 < j)) ? 1 : 0;
        rank += (o.z > score || (o.z == score && i + 2 < j)) ? 1 : 0;
        rank += (o.w > score || (o.w == score && i + 3 < j)) ? 1 : 0;
      }
      __builtin_amdgcn_wave_barrier();
      unsigned long long mk = __ballot(rank < 16);
      if (lane == 0) selm[q] = mk;
      un |= mk;
    }
    if (lane == 0) selu[wid] = un;
  }
  __syncthreads();
  const unsigned long long uni = selu[0] | selu[1] | selu[2] | selu[3];
  f32x4* OUTL = reinterpret_cast<f32x4*>(psum) + tid;
#pragma unroll
  for (int ni = 0; ni < 2; ++ni)
#pragma unroll
    for (int me = 0; me < 4; ++me) OUTL[(me * 2 + ni) * 256] = O[me][ni];
  unsigned long long msk[2];
#pragma unroll
  for (int ni = 0; ni < 2; ++ni) {
    msk[ni] = selm[wid * 8 + ni * 4 + (c16 >> 2)];
    unsigned mlo = (unsigned)(msk[ni] & 0xffffffffull), mhi = (unsigned)(msk[ni] >> 32);
    asm volatile("" : "+v"(mlo), "+v"(mhi));
    msk[ni] = ((unsigned long long)mhi << 32) | mlo;
  }
  unsigned uni_lo = (unsigned)(uni & 0xffffffffull), uni_hi = (unsigned)(uni >> 32);
  asm volatile("" : "+v"(uni_lo), "+v"(uni_hi));
  unsigned char* const stg[2] = {sm, sm + 49152};
  const int jhi = t0 >> 6;
  {
#pragma unroll
    for (int i = 0; i < 4; ++i) { O[i][0] = f32x4{0.f, 0.f, 0.f, 0.f}; O[i][1] = f32x4{0.f, 0.f, 0.f, 0.f}; }
    m[0] = m[1] = 0.f; l[0] = l[1] = 0.f;
    load_tile_dma(stg[0], p + 768 + gg * 64, LDCD, 64);
    load_tile_dma(stg[0] + 8192, vts, T_, 64);
    asm volatile("s_waitcnt vmcnt(0)" ::: "memory");
    __syncthreads();
    for (int jb = 0; jb <= jhi; ++jb) {
      const int st = jb & 1;
      if (jb < jhi) {
        load_tile_dma(stg[st ^ 1], p + (size_t)((jb + 1) * 64) * LDCD + 768 + gg * 64, LDCD, 64);
        load_tile_dma(stg[st ^ 1] + 8192, vts + (jb + 1) * 64, T_, 64);
      }
      const int kbase = jb * 64;
      const bool sel0 = (msk[0] >> jb) & 1ull, sel1 = (msk[1] >> jb) & 1ull;
      if (jb == jhi) {
        flash_tile<4>(O, m, l, qf, stg[st], stg[st] + 8192, true, jb == 0, lane,
                      [&](int key, int ni) { return (ni ? sel1 : sel0) && (kbase + key <= tq[ni]); });
      } else {
        const bool allsel = __all(sel0 && sel1);
        if (__any(sel0 || sel1))
          flash_tile<4>(O, m, l, qf, stg[st], stg[st] + 8192, !allsel, jb == 0, lane,
                        [&](int key, int ni) { return ni ? sel1 : sel0; });
      }
      asm volatile("s_waitcnt vmcnt(0)" ::: "memory");
      __syncthreads();
    }
#pragma unroll
    for (int ni = 0; ni < 2; ++ni) {
      l[ni] += __shfl_xor(l[ni], 16); l[ni] += __shfl_xor(l[ni], 32);
      float sc = (l[ni] > 0.f) ? gate[ni][1] / l[ni] : 0.f;
#pragma unroll
      for (int me = 0; me < 4; ++me) {
        f32x4 a = OUTL[(me * 2 + ni) * 256];
#pragma unroll
        for (int j = 0; j < 4; ++j) a[j] += sc * O[me][ni][j];
        OUTL[(me * 2 + ni) * 256] = a;
      }
    }
  }
  {
#pragma unroll
    for (int i = 0; i < 4; ++i) { O[i][0] = f32x4{0.f, 0.f, 0.f, 0.f}; O[i][1] = f32x4{0.f, 0.f, 0.f, 0.f}; }
    m[0] = m[1] = 0.f; l[0] = l[1] = 0.f;
    const int jlo = max(0, t0 - 511) >> 6;
    load_tile_dma(stg[0], p + (size_t)(jlo * 64) * LDCD + 1024 + gg * 64, LDCD, 64);
    load_tile_dma(stg[0] + 8192, vtw + jlo * 64, T_, 64);
    asm volatile("s_waitcnt vmcnt(0)" ::: "memory");
    __syncthreads();
    for (int jb = jlo; jb <= jhi; ++jb) {
      const int st = (jb - jlo) & 1;
      if (jb < jhi) {
        load_tile_dma(stg[st ^ 1], p + (size_t)((jb + 1) * 64) * LDCD + 1024 + gg * 64, LDCD, 64);
        load_tile_dma(stg[st ^ 1] + 8192, vtw + (jb + 1) * 64, T_, 64);
      }
      const int kbase = jb * 64;
      const bool edge = (jb == jhi) || (kbase <= t0 + 31 - 512);
      flash_tile<4>(O, m, l, qf, stg[st], stg[st] + 8192, edge, jb == jlo, lane,
                    [&](int key, int ni) { int kp = kbase + key; return (kp <= tq[ni]) && (kp > tq[ni] - 512); });
      asm volatile("s_waitcnt vmcnt(0)" ::: "memory");
      __syncthreads();
    }
#pragma unroll
    for (int ni = 0; ni < 2; ++ni) {
      l[ni] += __shfl_xor(l[ni], 16); l[ni] += __shfl_xor(l[ni], 32);
      float sc = (l[ni] > 0.f) ? gate[ni][2] / l[ni] : 0.f;
#pragma unroll
      for (int me = 0; me < 4; ++me) {
        f32x4 a = OUTL[(me * 2 + ni) * 256];
#pragma unroll
        for (int j = 0; j < 4; ++j) O[me][ni][j] = a[j] + sc * O[me][ni][j];
      }
    }
  }
#pragma unroll
  for (int ni = 0; ni < 2; ++ni)
#pragma unroll
    for (int me = 0; me < 4; ++me)
      *reinterpret_cast<uint2*>(mix + (size_t)(b * T_ + tq[ni]) * DM + (gg * 4 + hh) * 64 + me * 16 + g * 4) =
          pack4(O[me][ni][0], O[me][ni][1], O[me][ni][2], O[me][ni][3]);
  __syncthreads();
}

__device__ __forceinline__ void mlstm_chain(KP P, int chain, int eh, unsigned char* sm) {
  const int tid = tidx(), lane = tid & 63, wid = tid >> 6, c16 = lane & 15, g = lane >> 4;
  const int b = chain >> 2, h = chain & 3;
  const bf16_t* p = reinterpret_cast<const bf16_t*>(P->ws + OFF_B) + (size_t)b * T_ * LDCD;
  float* hbuf = reinterpret_cast<float*>(P->ws + OFF_Y);
  const int Q0 = 1304 + h * 64, K0 = 1560 + h * 64, V0 = 1816 + h * 128 + eh * 64, I0 = 2328 + h, F0 = 2332 + h;
  unsigned char* qs = sm;
  unsigned char* ks_ = sm + 8192;
  unsigned char* kTw = sm + 16384;
  unsigned char* vTa = sm + 24576;
  unsigned char* Cs = vTa + 10240;
  float* fa = reinterpret_cast<float*>(Cs + 10240);
  float* bcum = fa; float* aarr = fa + 64; float* msv = fa + 128; float* cwv = fa + 192;
  unsigned char* rawq = sm + 46592;
  unsigned char* rawk = rawq + 8704;
  const float* convw = P->in[33]; const float* convb = P->in[34];
  const float igb = P->in[35][h], fgb = P->in[36][h];
  typedef __attribute__((address_space(3))) unsigned* ldsp_t;
  auto issue_raw = [&](int tq) {
    for (int i = tid; i < 67 * 8; i += NTHR) {
      int r = i >> 3, c = (i & 7) ^ (r & 7);
      int tk = max(tq - 3 + r, 0);
      __builtin_amdgcn_global_load_lds((const unsigned*)(p + (size_t)tk * LDCD + Q0 + c * 8), (ldsp_t)(rawq + i * 16), 16, 0, 0);
      __builtin_amdgcn_global_load_lds((const unsigned*)(p + (size_t)tk * LDCD + K0 + c * 8), (ldsp_t)(rawk + i * 16), 16, 0, 0);
    }
  };
  for (int i = tid; i < 10240 / 4; i += NTHR) reinterpret_cast<unsigned*>(Cs)[i] = 0u;
  for (int i = tid; i < 16 * 64; i += NTHR) {
    int r = 64 + (i >> 6), c = i & 63;
    *reinterpret_cast<bf16_t*>(vTa + swz(r, c >> 3) + (c & 7) * 2) = (r == 64) ? (bf16_t)0x3f80 : (bf16_t)0;
  }
  f32x4 Cst[5];
#pragma unroll
  for (int i = 0; i < 5; ++i) Cst[i] = f32x4{0.f, 0.f, 0.f, 0.f};
  float mrun = 0.f;
  bf16_t gi_raw = p[(size_t)lane * LDCD + I0], gf_raw = p[(size_t)lane * LDCD + F0];
  const int wu = __builtin_amdgcn_readfirstlane(wid);
  uint4 vraw[2];
  {
    const bf16_t* vr0 = p + (size_t)lane * LDCD + V0 + wu * 16;
    vraw[0] = *reinterpret_cast<const uint4*>(vr0); vraw[1] = *reinterpret_cast<const uint4*>(vr0 + 8);
  }
  issue_raw(0);
  asm volatile("s_waitcnt vmcnt(0)" ::: "memory");
  if (tid < 24) {
    *reinterpret_cast<uint4*>(rawq + tid * 16) = make_uint4(0, 0, 0, 0);
    *reinterpret_cast<uint4*>(rawk + tid * 16) = make_uint4(0, 0, 0, 0);
  }
  __syncthreads();
  for (int t0 = 0; t0 < T_; t0 += 64) {
    float wr, dcy, mnew;
    {
      float li = bf2f(gi_raw) + igb;
      float lf = -softplusf_(-(bf2f(gf_raw) + fgb));
      float bc = wave_scan_add(lf);
      float a = li - bc;
      float pm = wave_scan_max(a);
      float ms = bc + fmaxf(mrun, pm);
      float cw = __expf(bc + mrun - ms);
      float blast = __int_as_float(__builtin_amdgcn_readlane(__float_as_int(bc), 63));
      float amax = __int_as_float(__builtin_amdgcn_readlane(__float_as_int(pm), 63));
      mnew = blast + fmaxf(mrun, amax);
      dcy = __expf(blast + mrun - mnew);
      wr = __expf(blast + a - mnew);
      if (wid == 0) { bcum[lane] = bc; aarr[lane] = a; msv[lane] = ms; cwv[lane] = cw; }
    }
    {
      const int r = lane;
#pragma unroll 1
      for (int which = 0; which < 2; ++which) {
        const unsigned char* raw = which ? rawk : rawq;
        const int chb = which * 256 + h * 64 + wu * 16;
        float qa[16];
#pragma unroll
        for (int i = 0; i < 16; ++i) qa[i] = convb[chb + i];
#pragma unroll
        for (int jj = 0; jj < 4; ++jj) {
          const int ri = r + jj;
          uint4 q0 = *reinterpret_cast<const uint4*>(raw + swz(ri, wu * 2)), q1 = *reinterpret_cast<const uint4*>(raw + swz(ri, wu * 2 + 1));
          const unsigned qw[8] = {q0.x, q0.y, q0.z, q0.w, q1.x, q1.y, q1.z, q1.w};
#pragma unroll
          for (int i = 0; i < 16; ++i)
            qa[i] += bf2f((unsigned short)(qw[i >> 1] >> ((i & 1) * 16))) * convw[jj * 512 + chb + i];
        }
        const float sc = which ? 1.f : 0.125f;
#pragma unroll
        for (int i = 0; i < 16; ++i) qa[i] = qa[i] * sigmoidf_(qa[i]) * sc;
        unsigned char* dstt = which ? ks_ : qs;
#pragma unroll
        for (int c = 0; c < 2; ++c)
          *reinterpret_cast<uint4*>(dstt + swz(r, wu * 2 + c)) = make_uint4(pack2(qa[c * 8], qa[c * 8 + 1]), pack2(qa[c * 8 + 2], qa[c * 8 + 3]),
                                                                         pack2(qa[c * 8 + 4], qa[c * 8 + 5]), pack2(qa[c * 8 + 6], qa[c * 8 + 7]));
        if (which) {
#pragma unroll
          for (int i = 0; i < 16; ++i) {
            int d = wu * 16 + i;
            *reinterpret_cast<bf16_t*>(kTw + swz(d, r >> 3) + (r & 7) * 2) = f2bf(qa[i] * wr);
          }
        }
      }
#pragma unroll
      for (int c = 0; c < 2; ++c) {
        const unsigned vw[4] = {vraw[c].x, vraw[c].y, vraw[c].z, vraw[c].w};
#pragma unroll
        for (int i = 0; i < 8; ++i) {
          int e = wu * 16 + c * 8 + i;
          *reinterpret_cast<bf16_t*>(vTa + swz(e, r >> 3) + (r & 7) * 2) = (bf16_t)(vw[i >> 1] >> ((i & 1) * 16));
        }
      }
    }
    __syncthreads();
    if (t0 + 64 < T_) {
      issue_raw(t0 + 64);
      const bf16_t* pr = p + (size_t)(t0 + 64 + lane) * LDCD;
      gi_raw = pr[I0]; gf_raw = pr[F0];
      vraw[0] = *reinterpret_cast<const uint4*>(pr + V0 + wu * 16); vraw[1] = *reinterpret_cast<const uint4*>(pr + V0 + wu * 16 + 8);
    }
    {
      const int s = wu * 16 + c16;
      bf16x8 qf[2] = {ldsfrag(qs, s, g), ldsfrag(qs, s, 4 + g)};
      f32x4 S[4];
#pragma unroll
      for (int mi = 0; mi < 4; ++mi) {
        S[mi] = f32x4{0.f, 0.f, 0.f, 0.f};
        if (mi <= wu) {
          S[mi] = MFMA(ldsfrag(ks_, mi * 16 + c16, g), qf[0], S[mi]);
          S[mi] = MFMA(ldsfrag(ks_, mi * 16 + c16, 4 + g), qf[1], S[mi]);
        }
      }
      const float bs = bcum[s], mss = msv[s], cws = cwv[s];
#pragma unroll
      for (int mi = 0; mi < 4; ++mi)
#pragma unroll
        for (int j = 0; j < 4; ++j) {
          int r = mi * 16 + g * 4 + j;
          float wgt = __expf((r <= s) ? (bs + aarr[r] - mss) : -100.f);
          S[mi][j] *= wgt;
        }
      bf16x8 pf[2] = {packfrag(S[0], S[1]), packfrag(S[2], S[3])};
      f32x4 acc[5];
#pragma unroll
      for (int me = 0; me < 5; ++me) {
        acc[me] = f32x4{0.f, 0.f, 0.f, 0.f};
        acc[me] = MFMA(ldsfrag(Cs, me * 16 + c16, g), qf[0], acc[me]);
        acc[me] = MFMA(ldsfrag(Cs, me * 16 + c16, 4 + g), qf[1], acc[me]);
        acc[me][0] *= cws; acc[me][1] *= cws; acc[me][2] *= cws; acc[me][3] *= cws;
        acc[me] = MFMA(ldsfragP(vTa, me * 16 + c16, 0, g), pf[0], acc[me]);
        if (wu >= 2) acc[me] = MFMA(ldsfragP(vTa, me * 16 + c16, 1, g), pf[1], acc[me]);
      }
      float den = __shfl(acc[4][0], c16);
      float hd = 1.f / fmaxf(fabsf(den), __expf(-mss));
      float* hrow = hbuf + (size_t)(b * T_ + t0 + s) * 512 + h * 128 + eh * 64;
#pragma unroll
      for (int me = 0; me < 4; ++me)
        *reinterpret_cast<float4*>(hrow + me * 16 + g * 4) = make_float4(acc[me][0] * hd, acc[me][1] * hd, acc[me][2] * hd, acc[me][3] * hd);
    }
    {
      bf16x8 kf0 = ldsfragP(kTw, wu * 16 + c16, 0, g), kf1 = ldsfragP(kTw, wu * 16 + c16, 1, g);
#pragma unroll
      for (int me = 0; me < 5; ++me) {
        Cst[me][0] *= dcy; Cst[me][1] *= dcy; Cst[me][2] *= dcy; Cst[me][3] *= dcy;
        Cst[me] = MFMA(ldsfragP(vTa, me * 16 + c16, 0, g), kf0, Cst[me]);
        Cst[me] = MFMA(ldsfragP(vTa, me * 16 + c16, 1, g), kf1, Cst[me]);
      }
    }
    mrun = mnew;
    asm volatile("s_waitcnt vmcnt(0)" ::: "memory");
    __syncthreads();
    {
      const int d = wu * 16 + c16;
#pragma unroll
      for (int me = 0; me < 5; ++me)
#pragma unroll
        for (int j = 0; j < 4; ++j) {
          int e = me * 16 + g * 4 + j;
          *reinterpret_cast<bf16_t*>(Cs + swz(e, d >> 3) + (d & 7) * 2) = f2bf(Cst[me][j]);
        }
    }
  }
  __syncthreads();
}

__device__ __forceinline__ void phase_mlstm_post(KP P) {
  const int tid = tidx(), lane = tid & 63, wid = tid >> 6;
  const float* hbuf = reinterpret_cast<const float*>(P->ws + OFF_Y);
  const bf16_t* pb = reinterpret_cast<const bf16_t*>(P->ws + OFF_B);
  bf16_t* mix = reinterpret_cast<bf16_t*>(P->ws + OFF_A);
  const float* normw = P->in[37];
  for (int task = bidx() * 4 + wid; task < MTOK * 4; task += gridDim.x * 4) {
    const int tok = task >> 2, h = task & 3;
    float2 hv = *reinterpret_cast<const float2*>(hbuf + (size_t)tok * 512 + h * 128 + lane * 2);
    unsigned ogu = *reinterpret_cast<const unsigned*>(pb + (size_t)tok * LDCD + 2336 + h * 128 + lane * 2);
    float2 nw = *reinterpret_cast<const float2*>(normw + h * 128 + lane * 2);
    float ss = hv.x * hv.x + hv.y * hv.y;
    for (int o = 32; o; o >>= 1) ss += __shfl_xor(ss, o);
    float rn = rsqrtf(ss * (1.f / 128.f) + 1e-6f);
    float o0 = hv.x * rn * nw.x * sigmoidf_(bf2f((unsigned short)(ogu & 0xffff)));
    float o1 = hv.y * rn * nw.y * sigmoidf_(bf2f((unsigned short)(ogu >> 16)));
    *reinterpret_cast<unsigned*>(mix + (size_t)tok * DM + 512 + h * 128 + lane * 2) = pack2(o0, o1);
  }
}

__device__ __forceinline__ void phase_mixCD(KP P, unsigned char* sm) {
  volatile int& s_item2 = *reinterpret_cast<volatile int*>(sm + 65532);
  if (bidx() < 64) mlstm_chain(P, bidx() >> 1, bidx() & 1, sm);
  unsigned* cnt = reinterpret_cast<unsigned*>(P->ws + OFF_MISC + 68);
  for (;;) {
    __syncthreads();
    if (tidx() == 0) s_item2 = (int)atomicAdd(cnt, 1u);
    __syncthreads();
    int item = s_item2;
    if (item >= 2048) break;
    nsa_item(P, item, sm);
  }
}


#define XB_TMO      128
#define XB_XCNT(j)  (256  + 64 * (j))
#define XB_XSUB(j)  (1280 + 64 * (j))
#define XB_XGEN(j)  (2304 + 64 * (j))
#define XB_TOP      3328
#define XB_TOPGEN   3392
#define XCD_BAR_WORDS 3456
#define XB_SPIN_CAP (1u << 22)
__device__ __forceinline__ unsigned xb_ld(unsigned* p) { return __hip_atomic_load(p, __ATOMIC_RELAXED, __HIP_MEMORY_SCOPE_AGENT); }
__device__ __forceinline__ unsigned xb_add(unsigned* p, unsigned v) { return __hip_atomic_fetch_add(p, v, __ATOMIC_RELAXED, __HIP_MEMORY_SCOPE_AGENT); }
__device__ __forceinline__ unsigned xb_xcc_id() { return (unsigned)__builtin_amdgcn_s_getreg((3 << 11) | 20) & 0xFu; }
#define XB_SPIN(cond, bar) do { unsigned _sp = 0; while (cond) { __builtin_amdgcn_s_sleep(1); \
    if ((++_sp & 255u) == 0u) { if (xb_ld(&(bar)[XB_TMO])) break; if (_sp > XB_SPIN_CAP) { atomicAdd(&(bar)[XB_TMO], 1u); break; } } } } while (0)
struct XcdBarrier { unsigned x, nloc, nx; };
__device__ __forceinline__ void xcd_barrier_complete(unsigned* bar, unsigned x, unsigned& nloc, unsigned& nx) {
  const unsigned G = gridDim.x;
  unsigned sum, cnt, mine, sp = 0u;
  for (;;) {
    sum = 0u; cnt = 0u; mine = 0u;
#pragma unroll
    for (unsigned j = 0; j < 16; ++j) { const unsigned c = xb_ld(&bar[XB_XCNT(j)]); sum += c; cnt += (c > 0u) ? 1u : 0u; mine = (j == x) ? c : mine; }
    if (sum == G) break;
    __builtin_amdgcn_s_sleep(1);
    if ((++sp & 255u) == 0u) { if (xb_ld(&bar[XB_TMO])) break; if (sp > XB_SPIN_CAP) { atomicAdd(&bar[XB_TMO], 1u); break; } }
  }
  nloc = mine > 0u ? mine : 1u; nx = cnt > 0u ? cnt : 1u;
}
__device__ __forceinline__ void xcd_barrier(XcdBarrier& b, KP kpp) {
  asm volatile("s_waitcnt vmcnt(0)" ::: "memory");
  __syncthreads();
  if (threadIdx.x == 0) {
    unsigned* bar = reinterpret_cast<unsigned*>(kp_launder(kpp)->ws + OFF_XBAR);
    __builtin_amdgcn_s_waitcnt(0);
    if (b.nloc == 0u) xcd_barrier_complete(bar, b.x, b.nloc, b.nx);
    const unsigned nloc = b.nloc, nx = b.nx;
    const unsigned old = xb_add(&bar[XB_XSUB(b.x)], 1u);
    const unsigned gen = old / nloc;
    if (old + 1u == (gen + 1u) * nloc) {
      __builtin_amdgcn_fence(__ATOMIC_RELEASE, "agent");
      asm volatile("s_waitcnt vmcnt(0)" ::: "memory");
      const unsigned og = xb_add(&bar[XB_TOP], 1u);
      const unsigned tg = og / nx;
      if (og + 1u == (tg + 1u) * nx) xb_add(&bar[XB_TOPGEN], 1u);
      else XB_SPIN(xb_ld(&bar[XB_TOPGEN]) == tg, bar);
      __builtin_amdgcn_fence(__ATOMIC_ACQUIRE, "agent");
      xb_add(&bar[XB_XGEN(b.x)], 1u);
      asm volatile("s_waitcnt vmcnt(0)" ::: "memory");
    } else {
      XB_SPIN(xb_ld(&bar[XB_XGEN(b.x)]) == gen, bar);
      __builtin_amdgcn_fence(__ATOMIC_ACQUIRE, "agent");
      asm volatile("s_waitcnt vmcnt(0)" ::: "memory");
    }
  }
  __syncthreads();
}

constexpr int NPHASE = 24;
enum { OP_RWKVPOST = 13, OP_MLSTMPOST = 14, OP_PREP = 0, OP_FNORM, OP_GATEUP, OP_DOWN, OP_MNORM, OP_WINAB, OP_MIXAB, OP_WOUT, OP_WINCD, OP_CMP1, OP_CMP2, OP_MIXCD, OP_FINAL };
template <int op>
__device__ __forceinline__ void run_op(KP P, const int f, unsigned char* sm) {
  unsigned char* ws = P->ws;
  bf16_t* xn = reinterpret_cast<bf16_t*>(ws + OFF_A);
  bf16_t* bufB = reinterpret_cast<bf16_t*>(ws + OFF_B);
  const float2* rope = reinterpret_cast<const float2*>(ws + OFF_ROPE);
  float* xres = P->out;
  switch (op) {
    case OP_PREP: phase_prep(P, sm); break;
    case OP_FNORM: {
      int layer = f >> 1; bool bsel = f & 1;
      const float* src = (f == 0) ? P->in[0] : xres;
      phase_rmsnorm(src, (bsel ? P->in[6] : P->in[1]) + layer * DM, xn);
    } break;
    case OP_GATEUP: {
      ALoadPlain al{xn, DM};
      EpiGateUp ep{bufB};
      gemm_phase(al, reinterpret_cast<const bf16_t*>(ws + OFF_WGU + f * SZ_WGU), DM, MTOK / 256, 44, ep, sm);
    } break;
    case OP_DOWN: {
      ALoadPlain al{bufB, FF};
      EpiResid ep{(f == 0) ? P->in[0] : xres, xres, 0.5f};
      gemm_phase(al, reinterpret_cast<const bf16_t*>(ws + OFF_WD + f * SZ_WD), FF, MTOK / 256, 8, ep, sm);
    } break;
    case OP_MNORM: phase_rmsnorm(xres, P->in[5] + f * DM, xn); break;
    case OP_WINAB: { ALoadPlain al{xn, DM}; EpiWinAB ep{bufB, reinterpret_cast<bf16_t*>(ws + OFF_C), rope};
              gemm_phase(al, reinterpret_cast<const bf16_t*>(ws + OFF_WINAB), DM, MTOK / 256, 26, ep, sm); } break;
    case OP_MIXAB: phase_mixAB(P, sm); break;
    case OP_RWKVPOST:
      for (int task = bidx(); task < 1024; task += gridDim.x) rwkv_work<1>(P, task >> 4, 0, (task & 15) * 256, (task & 15) * 256 + 256, sm);
      break;
    case OP_WOUT: { ALoadPlain al{xn, DM}; EpiResid ep{xres, xres, 1.f};
              gemm_phase(al, reinterpret_cast<const bf16_t*>(ws + (f ? OFF_WOUTCD : OFF_WOUTAB)), DM, MTOK / 256, 8, ep, sm); } break;
    case OP_WINCD: { ALoadPlain al{xn, DM};
               EpiWinCD ep{bufB, reinterpret_cast<bf16_t*>(ws + OFF_VTS), reinterpret_cast<bf16_t*>(ws + OFF_VTW), rope};
               gemm_phase(al, reinterpret_cast<const bf16_t*>(ws + OFF_WINCD), DM, MTOK / 256, 23, ep, sm); } break;
    case OP_CMP1: {
      const float* bias = reinterpret_cast<const float*>(ws + OFF_BIAS1);
      for (int i = bidx(); i < 64; i += gridDim.x) {
        int kv = i >> 5, r = i & 31, tm = r >> 1, tn = r & 1;
        ALoadCmp al{bufB, kv ? 640 : 512};
        EpiCmp1 ep{reinterpret_cast<bf16_t*>(ws + (kv ? OFF_HIDV : OFF_HIDK)), bias + kv * 256};
        gemm_tile(al, reinterpret_cast<const bf16_t*>(ws + (kv ? OFF_W1V : OFF_W1K)), 2048, tm, tn, ep, sm);
      }
    } break;
    case OP_CMP2: {
      phase_cmp2(P, rope);
    } break;
    case OP_MIXCD: phase_mixCD(P, sm); break;
    case OP_FINAL: phase_finalnorm(xres, P->in[38]); break;
    case OP_MLSTMPOST: phase_mlstm_post(P); break;
  }
}

#if MEGA
#define GSYNC xcd_barrier(xb, kp)
__global__ void __launch_bounds__(NTHR, 2) mega_kernel(Params P) {
  __shared__ __attribute__((aligned(16))) unsigned char sm[65536];
  cg::grid_group grid = cg::this_grid();
  KP kp = (KP)__builtin_amdgcn_kernarg_segment_ptr();
  run_op<OP_PREP>(kp_launder(kp), 0, sm);
  run_op<OP_FNORM>(kp_launder(kp), 0, sm);
  grid.sync();
  XcdBarrier xb;
  xb.x = xb_xcc_id(); xb.nloc = 0u; xb.nx = 0u;
  if (threadIdx.x == 0) (void)xb_add(&reinterpret_cast<unsigned*>(kp->ws + OFF_XBAR)[XB_XCNT(xb.x)], 1u);
  run_op<OP_GATEUP>(kp_launder(kp), 0, sm); GSYNC;
  run_op<OP_DOWN>(kp_launder(kp), 0, sm); GSYNC;
  run_op<OP_MNORM>(kp_launder(kp), 0, sm); GSYNC;
  run_op<OP_WINAB>(kp_launder(kp), 0, sm); GSYNC;
  run_op<OP_MIXAB>(kp_launder(kp), 0, sm); GSYNC;
  run_op<OP_RWKVPOST>(kp_launder(kp), 0, sm); GSYNC;
  run_op<OP_WOUT>(kp_launder(kp), 0, sm); GSYNC;
  run_op<OP_FNORM>(kp_launder(kp), 1, sm); GSYNC;
  run_op<OP_GATEUP>(kp_launder(kp), 1, sm); GSYNC;
  run_op<OP_DOWN>(kp_launder(kp), 1, sm); GSYNC;
  run_op<OP_FNORM>(kp_launder(kp), 2, sm); GSYNC;
  run_op<OP_GATEUP>(kp_launder(kp), 2, sm); GSYNC;
  run_op<OP_DOWN>(kp_launder(kp), 2, sm); GSYNC;
  run_op<OP_MNORM>(kp_launder(kp), 1, sm); GSYNC;
  run_op<OP_WINCD>(kp_launder(kp), 0, sm); GSYNC;
  run_op<OP_CMP1>(kp_launder(kp), 0, sm); GSYNC;
  run_op<OP_CMP2>(kp_launder(kp), 0, sm); GSYNC;
  run_op<OP_MIXCD>(kp_launder(kp), 0, sm); GSYNC;
  run_op<OP_MLSTMPOST>(kp_launder(kp), 0, sm); GSYNC;
  run_op<OP_WOUT>(kp_launder(kp), 1, sm); GSYNC;
  run_op<OP_FNORM>(kp_launder(kp), 3, sm); GSYNC;
  run_op<OP_GATEUP>(kp_launder(kp), 3, sm); GSYNC;
  run_op<OP_DOWN>(kp_launder(kp), 3, sm); GSYNC;
  run_op<OP_FINAL>(kp_launder(kp), 0, sm);
}
#else
template <int OP>
__global__ void __launch_bounds__(NTHR, 2) phase_kernel(Params P, int f) {
  __shared__ __attribute__((aligned(16))) unsigned char sm[65536];
  run_op<OP>((KP)__builtin_amdgcn_kernarg_segment_ptr(), f, sm);
}
#endif

extern "C" void kernel_launch(void* const* d_in, const int* in_sizes, int n_in, void* d_out, int out_size, void* d_ws,
                              size_t ws_size, hipStream_t stream) {
  Params P;
  memset(&P, 0, sizeof(P));
  for (int i = 0; i < 39; ++i) P.in[i] = (const float*)d_in[i];
  P.out = (float*)d_out;
  P.ws = (unsigned char*)d_ws;
#if MEGA
  static int grid_blocks = 0;
  if (!grid_blocks) {
    int dev = 0, cus = 0, per_cu = 0;
    (void)hipGetDevice(&dev);
    (void)hipDeviceGetAttribute(&cus, hipDeviceAttributeMultiprocessorCount, dev);
    (void)hipOccupancyMaxActiveBlocksPerMultiprocessor(&per_cu, mega_kernel, NTHR, 0);
    if (per_cu > 2) per_cu = 2;
    if (per_cu < 1) per_cu = 1;
    grid_blocks = cus * per_cu;
  }
  void* args[] = {&P};
  hipError_t e = hipLaunchCooperativeKernel((void*)mega_kernel, dim3(grid_blocks), dim3(NTHR), args, 0, stream);
  if (e != hipSuccess) fprintf(stderr, "cooperative launch failed: %s (grid %d)\n", hipGetErrorString(e), grid_blocks);
#else
#define LP(OP, F) phase_kernel<OP><<<512, NTHR, 0, stream>>>(P, F)
  LP(OP_PREP, 0);
  for (int layer = 0; layer < 2; ++layer) {
    LP(OP_FNORM, 2 * layer); LP(OP_GATEUP, 2 * layer); LP(OP_DOWN, 2 * layer); LP(OP_MNORM, layer);
    if (layer == 0) { LP(OP_WINAB, 0); LP(OP_MIXAB, 0); LP(OP_RWKVPOST, 0); }
    else { LP(OP_WINCD, 0); LP(OP_CMP1, 0); LP(OP_CMP2, 0); LP(OP_MIXCD, 0); LP(OP_MLSTMPOST, 0); }
    LP(OP_WOUT, layer); LP(OP_FNORM, 2 * layer + 1); LP(OP_GATEUP, 2 * layer + 1); LP(OP_DOWN, 2 * layer + 1);
  }
  LP(OP_FINAL, 0);
#endif
}
```

```cpp
#include <hip/hip_runtime.h>
#include <hip/hip_cooperative_groups.h>
#include <stdint.h>
#include <cstdio>
#include <cstring>
namespace cg = cooperative_groups;

#ifndef MEGA
#define MEGA 1
#endif

typedef unsigned short bf16_t;
using bf16x8 = __attribute__((ext_vector_type(8))) short;
using f32x4 = __attribute__((ext_vector_type(4))) float;
using f32x2 = __attribute__((ext_vector_type(2))) float;

#define NTHR 256
constexpr int T_ = 4096, NB_ = 8, DM = 1024, FF = 2816, MTOK = NB_ * T_;
constexpr int LDAB = 3328, LDCD = 2944;
constexpr size_t MiB = 1048576;
constexpr size_t OFF_WGU = 0;
constexpr size_t SZ_WGU = 11 * MiB;
constexpr size_t OFF_WD = 44 * MiB;
constexpr size_t SZ_WD = 5767168;
constexpr size_t OFF_WINAB = 66 * MiB;
constexpr size_t OFF_WINCD = OFF_WINAB + 6815744;
constexpr size_t OFF_WOUTAB = OFF_WINCD + 6029312;
constexpr size_t OFF_WOUTCD = OFF_WOUTAB + 2 * MiB;
constexpr size_t OFF_W1K = OFF_WOUTCD + 2 * MiB;
constexpr size_t OFF_W1V = OFF_W1K + MiB;
constexpr size_t OFF_W2K = OFF_W1V + MiB;
constexpr size_t OFF_W2V = OFF_W2K + 65536;
constexpr size_t OFF_ROPE = OFF_W2V + 65536;
constexpr size_t OFF_BIAS1 = OFF_ROPE + MiB;
constexpr size_t OFF_MISC = OFF_BIAS1 + 4096;
constexpr size_t OFF_XBAR = OFF_MISC + 4096;
constexpr size_t OFF_A = 88 * MiB;
constexpr size_t OFF_B = 152 * MiB;
constexpr size_t OFF_C = 360 * MiB;
constexpr size_t OFF_Y = 400 * MiB;
constexpr size_t OFF_VTS = OFF_C;
constexpr size_t OFF_VTW = OFF_C + 8 * MiB;
constexpr size_t OFF_HIDK = OFF_C + 16 * MiB;
constexpr size_t OFF_HIDV = OFF_C + 18 * MiB;
constexpr size_t OFF_KCMP = OFF_C + 20 * MiB;
constexpr size_t OFF_VCMPT = OFF_C + 21 * MiB;

struct TJob { const float* src; bf16_t* dst; int K, N, mode, tstart; };
struct Params {
  const float* in[39];
  float* out;
  unsigned char* ws;
};
typedef const __attribute__((address_space(4))) Params* KP;
__device__ __forceinline__ KP kp_launder(KP p) { asm volatile("" : "+s"(p)); return p; }
__device__ __forceinline__ int tidx() { int t = threadIdx.x; asm volatile("" : "+v"(t)); return t; }
__device__ __forceinline__ int bidx() { int t = blockIdx.x; asm volatile("" : "+s"(t)); return t; }
constexpr int TR_FFN = 16 * 44 * 3;
constexpr int TR_TOTAL = 4 * TR_FFN + 16 * 52 + 16 * 45 + 2 * 256 + 2 * 128 + 2 * 4;

__device__ __forceinline__ unsigned short f2bf(float f) {
  unsigned u = __float_as_uint(f); u += 0x7fffu + ((u >> 16) & 1u); return (unsigned short)(u >> 16);
}
__device__ __forceinline__ float bf2f(unsigned short h) { return __uint_as_float(((unsigned)h) << 16); }
__device__ __forceinline__ unsigned pack2(float a, float b) { unsigned r; asm("v_cvt_pk_bf16_f32 %0, %1, %2" : "=v"(r) : "v"(a), "v"(b)); return r; }
__device__ __forceinline__ uint2 pack4(float a, float b, float c, float d) { return make_uint2(pack2(a, b), pack2(c, d)); }
__device__ __forceinline__ float sigmoidf_(float x) { return 1.f / (1.f + __expf(-x)); }
__device__ __forceinline__ float softplusf_(float x) { return fmaxf(x, 0.f) + log1pf(__expf(-fabsf(x))); }
__device__ __forceinline__ float ftanhf_(float x) { float e = __expf(2.f * x); return 1.f - 2.f / (e + 1.f); }
__device__ __forceinline__ int swz(int row, int chunk) { return row * 128 + ((chunk ^ (row & 7)) << 4); }
__device__ __forceinline__ bf16x8 ldsfrag(const unsigned char* tile, int row, int chunk) {
  return *reinterpret_cast<const bf16x8*>(tile + swz(row, chunk));
}
__device__ __forceinline__ bf16x8 ldsfragP(const unsigned char* tile, int row, int s, int g) {
  const unsigned char* r = tile + row * 128 + (g & 1) * 8;
  int c0 = 4 * s + (g >> 1), c1 = c0 + 2, x = row & 7;
  uint2 a = *reinterpret_cast<const uint2*>(r + ((c0 ^ x) << 4));
  uint2 b = *reinterpret_cast<const uint2*>(r + ((c1 ^ x) << 4));
  union { uint4 u; bf16x8 v; } cv; cv.u = make_uint4(a.x, a.y, b.x, b.y); return cv.v;
}
__device__ __forceinline__ bf16x8 packfrag(const f32x4& a, const f32x4& b) {
  union { uint4 u; bf16x8 v; } cv;
  cv.u = make_uint4(pack2(a[0], a[1]), pack2(a[2], a[3]), pack2(b[0], b[1]), pack2(b[2], b[3])); return cv.v;
}
__device__ __forceinline__ bf16x8 u4frag(uint4 u) { union { uint4 u; bf16x8 v; } cv; cv.u = u; return cv.v; }

template <int CTRL>
__device__ __forceinline__ float dppf(float x) {
  return __int_as_float(__builtin_amdgcn_update_dpp(0, __float_as_int(x), CTRL, 0xF, 0xF, true));
}
__device__ __forceinline__ float red4(float x) { x += dppf<0xB1>(x); x += dppf<0x4E>(x); return x; }
__device__ __forceinline__ float red16(float x) { x = red4(x); x += dppf<0x124>(x); x += dppf<0x128>(x); return x; }

template <int CTRL, int RMASK>
__device__ __forceinline__ float dppo(float oldv, float x) {
  return __int_as_float(__builtin_amdgcn_update_dpp(__float_as_int(oldv), __float_as_int(x), CTRL, RMASK, 0xF, false));
}
__device__ __forceinline__ float wave_scan_add(float x) {
  x += dppo<0x111, 0xF>(0.f, x); x += dppo<0x112, 0xF>(0.f, x); x += dppo<0x114, 0xF>(0.f, x); x += dppo<0x118, 0xF>(0.f, x);
  x += dppo<0x142, 0xA>(0.f, x); x += dppo<0x143, 0xC>(0.f, x);
  return x;
}
__device__ __forceinline__ float wave_scan_max(float x) {
  x = fmaxf(x, dppo<0x111, 0xF>(-3e38f, x)); x = fmaxf(x, dppo<0x112, 0xF>(-3e38f, x));
  x = fmaxf(x, dppo<0x114, 0xF>(-3e38f, x)); x = fmaxf(x, dppo<0x118, 0xF>(-3e38f, x));
  x = fmaxf(x, dppo<0x142, 0xA>(-3e38f, x)); x = fmaxf(x, dppo<0x143, 0xC>(-3e38f, x));
  return x;
}
__device__ __forceinline__ float ex2(float x) { return __builtin_amdgcn_exp2f(x); }
#define MFMA(a, b, c) __builtin_amdgcn_mfma_f32_16x16x32_bf16(a, b, c, 0, 0, 0)

__device__ __forceinline__ void transpose_tile(KP P, int tile, unsigned char* smraw) {
  float* sm = reinterpret_cast<float*>(smraw);
  const int tid = tidx();
    TJob J;
    if (tile < 4 * TR_FFN) {
      int f = tile / TR_FFN, r = tile - f * TR_FFN, w = r / 704;
      int layer = f >> 1; bool bsel = f & 1;
      const float* g0 = bsel ? P->in[7] : P->in[2];
      const float* u0 = bsel ? P->in[8] : P->in[3];
      const float* d0 = bsel ? P->in[9] : P->in[4];
      J.src = (w == 0 ? g0 : (w == 1 ? u0 : d0)) + (size_t)layer * DM * FF;
      J.dst = reinterpret_cast<bf16_t*>(P->ws + (w < 2 ? OFF_WGU + f * SZ_WGU : OFF_WD + f * SZ_WD));
      J.K = (w < 2) ? DM : FF; J.N = (w < 2) ? FF : DM; J.mode = (w == 0) ? 1 : (w == 1 ? 2 : 0);
      J.tstart = f * TR_FFN + w * 704;
    } else {
      int r = tile - 4 * TR_FFN;
      if (r < 832) { J.src = P->in[10]; J.dst = reinterpret_cast<bf16_t*>(P->ws + OFF_WINAB); J.K = DM; J.N = 3328; J.tstart = 4 * TR_FFN; }
      else if (r < 1552) { J.src = P->in[25]; J.dst = reinterpret_cast<bf16_t*>(P->ws + OFF_WINCD); J.K = DM; J.N = 2848; J.tstart = 4 * TR_FFN + 832; }
      else if (r < 1808) { J.src = P->in[11]; J.dst = reinterpret_cast<bf16_t*>(P->ws + OFF_WOUTAB); J.K = DM; J.N = DM; J.tstart = 4 * TR_FFN + 1552; }
      else if (r < 2064) { J.src = P->in[26]; J.dst = reinterpret_cast<bf16_t*>(P->ws + OFF_WOUTCD); J.K = DM; J.N = DM; J.tstart = 4 * TR_FFN + 1808; }
      else if (r < 2192) { J.src = P->in[28]; J.dst = reinterpret_cast<bf16_t*>(P->ws + OFF_W1K); J.K = 2048; J.N = 256; J.tstart = 4 * TR_FFN + 2064; }
      else if (r < 2320) { J.src = P->in[31]; J.dst = reinterpret_cast<bf16_t*>(P->ws + OFF_W1V); J.K = 2048; J.N = 256; J.tstart = 4 * TR_FFN + 2192; }
      else if (r < 2324) { J.src = P->in[29]; J.dst = reinterpret_cast<bf16_t*>(P->ws + OFF_W2K); J.K = 256; J.N = 64; J.tstart = 4 * TR_FFN + 2320; }
      else { J.src = P->in[32]; J.dst = reinterpret_cast<bf16_t*>(P->ws + OFF_W2V); J.K = 256; J.N = 64; J.tstart = 4 * TR_FFN + 2324; }
      J.mode = 0;
    }
    int lt = tile - J.tstart;
    int nkt = J.K >> 6;
    int kt = lt % nkt, nt = lt / nkt;
    int k0 = kt * 64, n0 = nt * 64;
    for (int i = tid; i < 4096; i += NTHR) {
      int r = i >> 6, c = i & 63, n = n0 + c;
      sm[r * 65 + c] = (n < J.N) ? J.src[(size_t)(k0 + r) * J.N + n] : 0.f;
    }
    __syncthreads();
    for (int i = tid; i < 4096; i += NTHR) {
      int c = i >> 6, r = i & 63, n = n0 + c;
      if (n < J.N) {
        int drow = (J.mode == 0) ? n : ((n >> 5) * 64 + (n & 31) + (J.mode == 2 ? 32 : 0));
        J.dst[(size_t)drow * J.K + k0 + r] = f2bf(sm[r * 65 + c]);
      }
    }
    __syncthreads();
}

constexpr int TR_EARLY = 2112 + 832;
__device__ __forceinline__ int tr_early_tile(int v) { return v < 2112 ? v : v - 2112 + 4 * TR_FFN; }
__device__ __forceinline__ int tr_late_tile(int v) { return v < 3 * TR_FFN ? v + TR_FFN : v - 3 * TR_FFN + 4 * TR_FFN + 832; }

__device__ __forceinline__ void phase_prep(KP P, unsigned char* smraw) {
  const int tid = tidx();
  for (int v = bidx(); v < TR_EARLY; v += gridDim.x) transpose_tile(P, tr_early_tile(v), smraw);
  const int gtid = bidx() * NTHR + tid, gsz = gridDim.x * NTHR;
  float2* rope = reinterpret_cast<float2*>(P->ws + OFF_ROPE);
  for (int i = gtid; i < T_ * 32; i += gsz) {
    int t = i >> 5, d = i & 31;
    float inv = powf(10000.f, -(float)(2 * d) / 64.f);
    float ang = (float)t * inv;
    rope[i] = make_float2(cosf(ang), sinf(ang));
  }
  {
    bf16_t* w = reinterpret_cast<bf16_t*>(P->ws + OFF_WINCD) + (size_t)2848 * 1024;
    for (int i = gtid; i < 96 * 1024; i += gsz) w[i] = 0;
    bf16_t* a = reinterpret_cast<bf16_t*>(P->ws + OFF_W2K) + 64 * 256;
    bf16_t* b = reinterpret_cast<bf16_t*>(P->ws + OFF_W2V) + 64 * 256;
    for (int i = gtid; i < 64 * 256; i += gsz) { a[i] = 0; b[i] = 0; }
  }
  if (bidx() < 2) {
    const float* pe = (bidx() == 0) ? P->in[27] : P->in[30];
    const float* w1 = (bidx() == 0) ? P->in[28] : P->in[31];
    float acc = 0.f;
    for (int k = 0; k < 2048; ++k) acc += pe[k] * w1[(size_t)k * 256 + tid];
    reinterpret_cast<float*>(P->ws + OFF_BIAS1)[bidx() * 256 + tid] = acc;
  }
  if (bidx() == 2 && tid < 64) {
    const float* lam = P->in[12];
    float a = lam[tid] * lam[64 + tid], b = lam[128 + tid] * lam[192 + tid];
    for (int o = 32; o; o >>= 1) { a += __shfl_xor(a, o); b += __shfl_xor(b, o); }
    if (tid == 0) {
      float* misc = reinterpret_cast<float*>(P->ws + OFF_MISC);
      misc[0] = expf(a) - expf(b) + 0.2f;
    }
  }
  if (bidx() == 4) {
    unsigned* xb = reinterpret_cast<unsigned*>(P->ws + OFF_XBAR);
    for (int i = tid; i < 3456; i += NTHR) xb[i] = 0u;
  }
  if (bidx() == 3 && tid == 0) {
    unsigned* cnt = reinterpret_cast<unsigned*>(P->ws + OFF_MISC + 64);
    cnt[0] = 0; cnt[1] = 0; cnt[2] = 0; cnt[3] = 0;
  }
}

__device__ __forceinline__ void phase_rmsnorm(const float* __restrict__ src, const float* __restrict__ w, bf16_t* __restrict__ dst) {
  const int lane = tidx() & 63, wid = tidx() >> 6;
  for (int row = bidx() * 4 + wid; row < MTOK; row += gridDim.x * 4) {
    const float4* s4 = reinterpret_cast<const float4*>(src + (size_t)row * DM);
    float4 v[4]; float ss = 0.f;
#pragma unroll
    for (int i = 0; i < 4; ++i) { v[i] = s4[lane + 64 * i]; ss += v[i].x * v[i].x + v[i].y * v[i].y + v[i].z * v[i].z + v[i].w * v[i].w; }
    for (int o = 32; o; o >>= 1) ss += __shfl_xor(ss, o);
    float r = rsqrtf(ss * (1.f / DM) + 1e-6f);
#pragma unroll
    for (int i = 0; i < 4; ++i) {
      float4 ww = reinterpret_cast<const float4*>(w)[lane + 64 * i];
      uint2 o = pack4(v[i].x * r * ww.x, v[i].y * r * ww.y, v[i].z * r * ww.z, v[i].w * r * ww.w);
      *reinterpret_cast<uint2*>(dst + (size_t)row * DM + (lane + 64 * i) * 4) = o;
    }
  }
}
__device__ __forceinline__ void phase_finalnorm(float* __restrict__ x, const float* __restrict__ w) {
  const int lane = tidx() & 63, wid = tidx() >> 6;
  for (int row = bidx() * 4 + wid; row < MTOK; row += gridDim.x * 4) {
    float4* s4 = reinterpret_cast<float4*>(x + (size_t)row * DM);
    float4 v[4]; float ss = 0.f;
#pragma unroll
    for (int i = 0; i < 4; ++i) { v[i] = s4[lane + 64 * i]; ss += v[i].x * v[i].x + v[i].y * v[i].y + v[i].z * v[i].z + v[i].w * v[i].w; }
    for (int o = 32; o; o >>= 1) ss += __shfl_xor(ss, o);
    float r = rsqrtf(ss * (1.f / DM) + 1e-6f);
#pragma unroll
    for (int i = 0; i < 4; ++i) {
      float4 ww = reinterpret_cast<const float4*>(w)[lane + 64 * i];
      s4[lane + 64 * i] = make_float4(v[i].x * r * ww.x, v[i].y * r * ww.y, v[i].z * r * ww.z, v[i].w * r * ww.w);
    }
  }
}

struct ALoadPlain {
  const bf16_t* A; int lda;
  __device__ __forceinline__ const bf16_t* ptr(int row, int kt) const { return A + (size_t)row * lda + kt * 64; }
};
struct ALoadCmp {
  const bf16_t* p; int colbase;
  __device__ __forceinline__ const bf16_t* ptr(int row, int kt) const {
    int bg = row >> 8, n = row & 255, b = bg >> 1, g = bg & 1;
    int t = min(16 * n + kt, T_ - 1);
    return p + ((size_t)(b * T_ + t)) * LDCD + colbase + g * 64;
  }
};

__device__ __forceinline__ int swz32(int row, int chunk) { return row * 64 + ((chunk ^ ((-(row >> 2)) & 3)) << 4); }
template <class AF, class EPI>
__device__ __forceinline__ void gemm_tile(const AF& af, const bf16_t* __restrict__ Bt, int K, int tm, int tn,
                                          const EPI& epi, unsigned char* sm, bool pre_issued = false, int ntm = -1, int ntn = -1) {
  const int tid = tidx(), lane = tid & 63, wid = tid >> 6;
  const int wm = wid >> 1, wn = wid & 1, c16 = lane & 15, g = lane >> 4;
  const int lr = tid >> 2, lc = tid & 3;
  const int nk = K >> 5;
  f32x4 acc[4][8];
#pragma unroll
  for (int i = 0; i < 4; ++i)
#pragma unroll
    for (int j = 0; j < 8; ++j) acc[i][j] = f32x4{0.f, 0.f, 0.f, 0.f};
  const int gc = (lc ^ ((-(lr >> 2)) & 3)) * 8;
  const bf16_t* bp = Bt + (size_t)(tn * 128 + lr) * K + gc;
  const int row0 = tm * 256 + lr;
  typedef __attribute__((address_space(3))) unsigned* ldsp_t;
#define GLD(KT, BASE) { const int k_ = (KT); const int ko_ = (k_ & 1) * 32 + gc;                                \
    unsigned char* d_ = (BASE) + tid * 16;                                                                      \
    __builtin_amdgcn_global_load_lds((const unsigned*)(af.ptr(row0, k_ >> 1) + ko_), (ldsp_t)(d_), 16, 0, 0);             \
    __builtin_amdgcn_global_load_lds((const unsigned*)(af.ptr(row0 + 64, k_ >> 1) + ko_), (ldsp_t)(d_ + 4096), 16, 0, 0);  \
    __builtin_amdgcn_global_load_lds((const unsigned*)(af.ptr(row0 + 128, k_ >> 1) + ko_), (ldsp_t)(d_ + 8192), 16, 0, 0); \
    __builtin_amdgcn_global_load_lds((const unsigned*)(af.ptr(row0 + 192, k_ >> 1) + ko_), (ldsp_t)(d_ + 12288), 16, 0, 0);\
    __builtin_amdgcn_global_load_lds((const unsigned*)(bp + k_ * 32), (ldsp_t)(d_ + 16384), 16, 0, 0);                    \
    __builtin_amdgcn_global_load_lds((const unsigned*)(bp + (size_t)64 * K + k_ * 32), (ldsp_t)(d_ + 20480), 16, 0, 0); }
#define CMP(BASE) { const unsigned char* sA_ = (BASE); const unsigned char* sB_ = sA_ + 16384;                 \
    bf16x8 wf[4], xf[8];                                                                                        \
    _Pragma("unroll") for (int i = 0; i < 4; ++i) wf[i] = *reinterpret_cast<const bf16x8*>(sB_ + swz32(wn * 64 + i * 16 + c16, g));   \
    _Pragma("unroll") for (int i = 0; i < 8; ++i) xf[i] = *reinterpret_cast<const bf16x8*>(sA_ + swz32(wm * 128 + i * 16 + c16, g));  \
    __builtin_amdgcn_s_setprio(1);                                                                              \
    _Pragma("unroll") for (int mi = 0; mi < 4; ++mi)                                                            \
      _Pragma("unroll") for (int ni = 0; ni < 8; ++ni) acc[mi][ni] = MFMA(wf[mi], xf[ni], acc[mi][ni]);         \
    __builtin_amdgcn_s_setprio(0); }
  if (!pre_issued) { GLD(0, sm) }
  asm volatile("s_waitcnt vmcnt(0)" ::: "memory");
  __syncthreads();
  for (int kt = 0; kt < nk; kt += 2) {
    GLD(kt + 1, sm + 24576)
    CMP(sm)
    asm volatile("s_waitcnt vmcnt(0)" ::: "memory");
    __syncthreads();
    if (kt + 2 < nk) { GLD(kt + 2, sm) }
    CMP(sm + 24576)
    asm volatile("s_waitcnt vmcnt(0)" ::: "memory");
    __syncthreads();
  }
#undef GLD
#undef CMP
  if (ntm >= 0) {
    const bf16_t* nbp = Bt + (size_t)(ntn * 128 + lr) * K + gc;
    const int nrow0 = ntm * 256 + lr;
    unsigned char* d_ = sm + tid * 16;
    __builtin_amdgcn_global_load_lds((const unsigned*)(af.ptr(nrow0, 0) + gc), (ldsp_t)(d_), 16, 0, 0);
    __builtin_amdgcn_global_load_lds((const unsigned*)(af.ptr(nrow0 + 64, 0) + gc), (ldsp_t)(d_ + 4096), 16, 0, 0);
    __builtin_amdgcn_global_load_lds((const unsigned*)(af.ptr(nrow0 + 128, 0) + gc), (ldsp_t)(d_ + 8192), 16, 0, 0);
    __builtin_amdgcn_global_load_lds((const unsigned*)(af.ptr(nrow0 + 192, 0) + gc), (ldsp_t)(d_ + 12288), 16, 0, 0);
    __builtin_amdgcn_global_load_lds((const unsigned*)(nbp), (ldsp_t)(d_ + 16384), 16, 0, 0);
    __builtin_amdgcn_global_load_lds((const unsigned*)(nbp + (size_t)64 * K), (ldsp_t)(d_ + 20480), 16, 0, 0);
  }
#pragma unroll
  for (int hf = 0; hf < 2; ++hf) {
    __builtin_amdgcn_sched_barrier(0);
    f32x4 sub[4][4];
#pragma unroll
    for (int mi = 0; mi < 4; ++mi)
#pragma unroll
      for (int ni = 0; ni < 4; ++ni) sub[mi][ni] = acc[mi][hf * 4 + ni];
    epi(sub, tm * 256 + wm * 128 + hf * 64, tn * 128 + wn * 64, lane);
  }
}

template <class AF, class EPI>
__device__ __forceinline__ void gemm_phase(const AF& af, const bf16_t* Bt, int K, int ntm, int ntn, const EPI& epi, unsigned char* sm) {
  const int total = ntm * ntn;
  bool pre = false;
  for (int i = bidx(); i < total; i += gridDim.x) {
    int x = i & 7, j = i >> 3;
    int grp = j / (8 * ntn), r = j - grp * 8 * ntn;
    int tn = r >> 3, tml = grp * 8 + (r & 7);
    int tm = tml * 8 + x;
    int i2 = i + gridDim.x, ntm2 = -1, ntn2 = -1;
    if (i2 < total) {
      int x2 = i2 & 7, j2 = i2 >> 3;
      int grp2 = j2 / (8 * ntn), r2 = j2 - grp2 * 8 * ntn;
      ntn2 = r2 >> 3; ntm2 = (grp2 * 8 + (r2 & 7)) * 8 + x2;
    }
    gemm_tile(af, Bt, K, tm, tn, epi, sm, pre, ntm2, ntn2);
    pre = (ntm2 >= 0);
  }
}

struct EpiGateUp {
  bf16_t* hid;
  __device__ __forceinline__ void operator()(f32x4 (&acc)[4][4], int tb, int cb, int lane) const {
    const int c16 = lane & 15, g = lane >> 4;
#pragma unroll
    for (int mi = 0; mi < 2; ++mi)
#pragma unroll
      for (int ni = 0; ni < 4; ++ni) {
        float h[4];
#pragma unroll
        for (int j = 0; j < 4; ++j) { float gg = acc[mi][ni][j], uu = acc[mi + 2][ni][j]; h[j] = gg / (1.f + __expf(-gg)) * uu; }
        int f = (cb >> 6) * 32 + mi * 16 + g * 4;
        int tok = tb + ni * 16 + c16;
        *reinterpret_cast<uint2*>(hid + (size_t)tok * FF + f) = pack4(h[0], h[1], h[2], h[3]);
      }
  }
};
struct EpiResid {
  const float* src; float* dst; float alpha;
  __device__ __forceinline__ void operator()(f32x4 (&acc)[4][4], int tb, int cb, int lane) const {
    const int c16 = lane & 15, g = lane >> 4;
#pragma unroll
    for (int mi = 0; mi < 4; ++mi) {
#pragma unroll
      for (int ni = 0; ni < 4; ++ni) {
        size_t o = (size_t)(tb + ni * 16 + c16) * DM + cb + mi * 16 + g * 4;
        float4 s = *reinterpret_cast<const float4*>(src + o);
        *reinterpret_cast<float4*>(dst + o) = make_float4(s.x + alpha * acc[mi][ni][0], s.y + alpha * acc[mi][ni][1],
                                                          s.z + alpha * acc[mi][ni][2], s.w + alpha * acc[mi][ni][3]);
      }
    }
  }
};
__device__ __forceinline__ void rope_wave(f32x4 (&acc)[4][4], int tb, int lane, const float2* rope, float scale) {
  const int c16 = lane & 15, g = lane >> 4;
#pragma unroll
  for (int ni = 0; ni < 4; ++ni) {
    int t = (tb + ni * 16 + c16) & (T_ - 1);
#pragma unroll
    for (int mi = 0; mi < 2; ++mi)
#pragma unroll
      for (int j = 0; j < 4; ++j) {
        float2 cs = rope[t * 32 + mi * 16 + g * 4 + j];
        float x1 = acc[mi][ni][j], x2 = acc[mi + 2][ni][j];
        acc[mi][ni][j] = (x1 * cs.x - x2 * cs.y) * scale;
        acc[mi + 2][ni][j] = (x2 * cs.x + x1 * cs.y) * scale;
      }
  }
}
__device__ __forceinline__ void store_p(f32x4 (&acc)[4][4], int tb, int cb, int lane, bf16_t* p, int ld) {
  const int c16 = lane & 15, g = lane >> 4;
#pragma unroll
  for (int mi = 0; mi < 4; ++mi)
#pragma unroll
    for (int ni = 0; ni < 4; ++ni)
      *reinterpret_cast<uint2*>(p + (size_t)(tb + ni * 16 + c16) * ld + cb + mi * 16 + g * 4) =
          pack4(acc[mi][ni][0], acc[mi][ni][1], acc[mi][ni][2], acc[mi][ni][3]);
}
__device__ __forceinline__ void store_vt(f32x4 (&acc)[4][4], int tb, int lane, bf16_t* vt, int ebase) {
  const int c16 = lane & 15, g = lane >> 4;
#pragma unroll
  for (int ni = 0; ni < 4; ++ni) {
    int t = (tb + ni * 16 + c16) & (T_ - 1);
#pragma unroll
    for (int mi = 0; mi < 4; ++mi)
#pragma unroll
      for (int j = 0; j < 4; ++j) vt[(size_t)(ebase + mi * 16 + g * 4 + j) * T_ + t] = f2bf(acc[mi][ni][j]);
  }
}
struct EpiWinAB {
  bf16_t* p; bf16_t* vta; const float2* rope;
  __device__ __forceinline__ void operator()(f32x4 (&acc)[4][4], int tb, int cb, int lane) const {
    if (cb < 1024) rope_wave(acc, tb, lane, rope, cb < 512 ? 0.125f * 1.4426950408889634f : 1.f);
    store_p(acc, tb, cb, lane, p, LDAB);
    if (cb >= 1024 && cb < 1536) {
      int b = tb >> 12;
      store_vt(acc, tb, lane, vta + (size_t)b * 512 * T_, cb - 1024);
    }
  }
};
struct EpiWinCD {
  bf16_t* p; bf16_t* vts; bf16_t* vtw; const float2* rope;
  __device__ __forceinline__ void operator()(f32x4 (&acc)[4][4], int tb, int cb, int lane) const {
    if (cb < 512) rope_wave(acc, tb, lane, rope, 0.125f * 1.4426950408889634f);
    else if ((cb >= 768 && cb < 896) || (cb >= 1024 && cb < 1152)) rope_wave(acc, tb, lane, rope, 1.f);
    store_p(acc, tb, cb, lane, p, LDCD);
    int b = tb >> 12;
    if (cb >= 896 && cb < 1024) store_vt(acc, tb, lane, vts + (size_t)b * 128 * T_, cb - 896);
    if (cb >= 1152 && cb < 1280) store_vt(acc, tb, lane, vtw + (size_t)b * 128 * T_, cb - 1152);
  }
};
struct EpiCmp1 {
  bf16_t* hid; const float* bias;
  __device__ __forceinline__ void operator()(f32x4 (&acc)[4][4], int tb, int cb, int lane) const {
    const int c16 = lane & 15, g = lane >> 4;
#pragma unroll
    for (int mi = 0; mi < 4; ++mi) {
      int c = cb + mi * 16 + g * 4;
      float4 bb = *reinterpret_cast<const float4*>(bias + c);
      float bv[4] = {bb.x, bb.y, bb.z, bb.w};
#pragma unroll
      for (int ni = 0; ni < 4; ++ni) {
        float h[4];
#pragma unroll
        for (int j = 0; j < 4; ++j) {
          float x = acc[mi][ni][j] + bv[j];
          float u = 0.7978845608028654f * (x + 0.044715f * x * x * x);
          h[j] = 0.5f * x * (1.f + tanhf(u));
        }
        *reinterpret_cast<uint2*>(hid + (size_t)(tb + ni * 16 + c16) * 256 + c) = pack4(h[0], h[1], h[2], h[3]);
      }
    }
  }
};
__device__ __forceinline__ void phase_cmp2(KP P, const float2* rope) {
  const int tid = tidx(), lane = tid & 63, wid = tid >> 6, c16 = lane & 15, g = lane >> 4;
  for (int task = bidx() * 4 + wid; task < 512; task += gridDim.x * 4) {
    const int kv = task >> 8, R0 = (task & 255) * 16;
    const bf16_t* hid = reinterpret_cast<const bf16_t*>(P->ws + (kv ? OFF_HIDV : OFF_HIDK));
    const bf16_t* w2 = reinterpret_cast<const bf16_t*>(P->ws + (kv ? OFF_W2V : OFF_W2K));
    f32x4 acc[4];
#pragma unroll
    for (int mi = 0; mi < 4; ++mi) acc[mi] = f32x4{0.f, 0.f, 0.f, 0.f};
#pragma unroll
    for (int ks = 0; ks < 8; ++ks) {
      bf16x8 xf = u4frag(*reinterpret_cast<const uint4*>(hid + (size_t)(R0 + c16) * 256 + ks * 32 + g * 8));
#pragma unroll
      for (int mi = 0; mi < 4; ++mi) {
        bf16x8 wf = u4frag(*reinterpret_cast<const uint4*>(w2 + (size_t)(mi * 16 + c16) * 256 + ks * 32 + g * 8));
        acc[mi] = MFMA(wf, xf, acc[mi]);
      }
    }
    const int R = R0 + c16, bg = R >> 8, n = R & 255;
    if (kv == 0) {
      bf16_t* dst = reinterpret_cast<bf16_t*>(P->ws + OFF_KCMP);
      int pos = min(16 * n + 31, T_ - 1);
#pragma unroll
      for (int mi = 0; mi < 2; ++mi)
#pragma unroll
        for (int j = 0; j < 4; ++j) {
          float2 cs = rope[pos * 32 + mi * 16 + g * 4 + j];
          float x1 = acc[mi][j], x2 = acc[mi + 2][j];
          acc[mi][j] = x1 * cs.x - x2 * cs.y;
          acc[mi + 2][j] = x2 * cs.x + x1 * cs.y;
        }
#pragma unroll
      for (int mi = 0; mi < 4; ++mi)
        *reinterpret_cast<uint2*>(dst + ((size_t)bg * 256 + n) * 64 + mi * 16 + g * 4) = pack4(acc[mi][0], acc[mi][1], acc[mi][2], acc[mi][3]);
    } else {
      bf16_t* dst = reinterpret_cast<bf16_t*>(P->ws + OFF_VCMPT);
#pragma unroll
      for (int mi = 0; mi < 4; ++mi)
#pragma unroll
        for (int j = 0; j < 4; ++j) dst[((size_t)bg * 64 + mi * 16 + g * 4 + j) * 256 + n] = f2bf(acc[mi][j]);
    }
  }
}

template <int EM, class MaskF>
__device__ __forceinline__ void flash_tile(f32x4 (&O)[EM][2], float (&m)[2], float (&l)[2], const bf16x8 (&qf)[2][2],
                                           const unsigned char* Ks, const unsigned char* Vs, bool domask, bool first, int lane,
                                           const MaskF& valid) {
  const int c16 = lane & 15, g = lane >> 4;
  f32x4 S[4][2];
#pragma unroll
  for (int mi = 0; mi < 4; ++mi) {
    S[mi][0] = f32x4{-m[0], -m[0], -m[0], -m[0]}; S[mi][1] = f32x4{-m[1], -m[1], -m[1], -m[1]};
#pragma unroll
    for (int ks = 0; ks < 2; ++ks) {
      bf16x8 kf = ldsfrag(Ks, mi * 16 + c16, ks * 4 + g);
      S[mi][0] = MFMA(kf, qf[0][ks], S[mi][0]);
      S[mi][1] = MFMA(kf, qf[1][ks], S[mi][1]);
    }
  }
  if (domask) {
#pragma unroll
    for (int mi = 0; mi < 4; ++mi)
#pragma unroll
      for (int ni = 0; ni < 2; ++ni)
#pragma unroll
        for (int j = 0; j < 4; ++j)
          if (!valid(mi * 16 + g * 4 + j, ni)) S[mi][ni][j] = -1e30f;
  }
  float mx[2];
#pragma unroll
  for (int ni = 0; ni < 2; ++ni) {
    float v = -1e30f;
#pragma unroll
    for (int mi = 0; mi < 4; ++mi)
#pragma unroll
      for (int j = 0; j < 4; ++j) v = fmaxf(v, S[mi][ni][j]);
    mx[ni] = v;
  }
  if (__any(first || mx[0] > 8.f || mx[1] > 8.f)) {
#pragma unroll
    for (int ni = 0; ni < 2; ++ni) {
      float v = mx[ni];
      v = fmaxf(v, __shfl_xor(v, 16));
      v = fmaxf(v, __shfl_xor(v, 32));
      float delta = (v > -1e29f) ? (first ? v : fmaxf(v, 0.f)) : 0.f;
      float al = ex2(-delta);
      m[ni] += delta;
      l[ni] *= al;
#pragma unroll
      for (int me = 0; me < EM; ++me) { O[me][ni][0] *= al; O[me][ni][1] *= al; O[me][ni][2] *= al; O[me][ni][3] *= al; }
#pragma unroll
      for (int mi = 0; mi < 4; ++mi) { S[mi][ni][0] -= delta; S[mi][ni][1] -= delta; S[mi][ni][2] -= delta; S[mi][ni][3] -= delta; }
    }
  }
#pragma unroll
  for (int ni = 0; ni < 2; ++ni) {
    float rs = 0.f;
#pragma unroll
    for (int mi = 0; mi < 4; ++mi)
#pragma unroll
      for (int j = 0; j < 4; ++j) {
        float pv = ex2(S[mi][ni][j]);
        S[mi][ni][j] = pv; rs += pv;
      }
    l[ni] += rs;
  }
  bf16x8 pf[2][2];
#pragma unroll
  for (int ni = 0; ni < 2; ++ni) { pf[ni][0] = packfrag(S[0][ni], S[1][ni]); pf[ni][1] = packfrag(S[2][ni], S[3][ni]); }
#pragma unroll
  for (int me = 0; me < EM; ++me)
#pragma unroll
    for (int s = 0; s < 2; ++s) {
      bf16x8 vf = ldsfragP(Vs, me * 16 + c16, s, g);
      O[me][0] = MFMA(vf, pf[0][s], O[me][0]);
      O[me][1] = MFMA(vf, pf[1][s], O[me][1]);
    }
}

__device__ __forceinline__ void load_tile(unsigned char* dst, const bf16_t* src, size_t ld, int rows) {
  for (int i = tidx(); i < rows * 8; i += NTHR) {
    int r = i >> 3, c = i & 7;
    *reinterpret_cast<uint4*>(dst + swz(r, c)) = *reinterpret_cast<const uint4*>(src + (size_t)r * ld + c * 8);
  }
}


__device__ __forceinline__ void load_tile_dma(unsigned char* dst, const bf16_t* src, size_t ld, int rows) {
  typedef __attribute__((address_space(3))) unsigned* ldsp_t;
  const int tid = tidx();
  for (int i = tid; i < rows * 8; i += NTHR) {
    int r = i >> 3, c = (i & 7) ^ (r & 7);
    __builtin_amdgcn_global_load_lds((const unsigned*)(src + (size_t)r * ld + c * 8), (ldsp_t)(dst + i * 16), 16, 0, 0);
  }
}

__device__ __forceinline__ void diffattn_item(KP P, int item, unsigned char* sm) {
  const int tid = tidx(), lane = tid & 63, wid = tid >> 6, c16 = lane & 15, g = lane >> 4;
  const int qb = 63 - (item >> 5);
  const int bh = item & 31, b = bh >> 2, h = bh & 3;
  const int comp = wid >> 1, qh = wid & 1;
  const bf16_t* p = reinterpret_cast<const bf16_t*>(P->ws + OFF_B) + (size_t)b * T_ * LDAB;
  const bf16_t* vt = reinterpret_cast<const bf16_t*>(P->ws + OFF_C) + (size_t)(b * 4 + h) * 128 * T_;
  bf16_t* mix = reinterpret_cast<bf16_t*>(P->ws + OFF_A);
  const int t0 = qb * 64, tq0 = t0 + qh * 32;
  bf16x8 qf[2][2];
#pragma unroll
  for (int ni = 0; ni < 2; ++ni)
#pragma unroll
    for (int ks = 0; ks < 2; ++ks)
      qf[ni][ks] = u4frag(*reinterpret_cast<const uint4*>(p + (size_t)(tq0 + ni * 16 + c16) * LDAB + h * 128 + comp * 64 + (ks * 4 + g) * 8));
  f32x4 O[8][2];
#pragma unroll
  for (int i = 0; i < 8; ++i) { O[i][0] = f32x4{0.f, 0.f, 0.f, 0.f}; O[i][1] = f32x4{0.f, 0.f, 0.f, 0.f}; }
  float m[2] = {0.f, 0.f}, l[2] = {0.f, 0.f};
  __syncthreads();
  load_tile_dma(sm, p + 512 + h * 128, LDAB, 64);
  load_tile_dma(sm + 8192, p + 512 + h * 128 + 64, LDAB, 64);
  load_tile_dma(sm + 16384, vt, T_, 128);
  asm volatile("s_waitcnt vmcnt(0)" ::: "memory");
  __syncthreads();
  for (int kt = 0; kt <= qb; ++kt) {
    unsigned char* cur = sm + (kt & 1) * 32768;
    if (kt < qb) {
      unsigned char* nxt = sm + ((kt + 1) & 1) * 32768;
      load_tile_dma(nxt, p + (size_t)((kt + 1) * 64) * LDAB + 512 + h * 128, LDAB, 64);
      load_tile_dma(nxt + 8192, p + (size_t)((kt + 1) * 64) * LDAB + 512 + h * 128 + 64, LDAB, 64);
      load_tile_dma(nxt + 16384, vt + (kt + 1) * 64, T_, 128);
    }
    const int kbase = kt * 64;
    flash_tile<8>(O, m, l, qf, cur + (comp ? 8192 : 0), cur + 16384, kt == qb, kt == 0, lane,
                  [&](int key, int ni) { return kbase + key <= tq0 + ni * 16 + c16; });
    asm volatile("s_waitcnt vmcnt(0)" ::: "memory");
    __syncthreads();
  }
#pragma unroll
  for (int ni = 0; ni < 2; ++ni) { l[ni] += __shfl_xor(l[ni], 16); l[ni] += __shfl_xor(l[ni], 32); }
  __syncthreads();
  float* X = reinterpret_cast<float*>(sm);
  const float lam = reinterpret_cast<const float*>(P->ws + OFF_MISC)[0];
  if (comp == 1) {
#pragma unroll
    for (int ni = 0; ni < 2; ++ni) {
      float sc = lam / l[ni];
#pragma unroll
      for (int me = 0; me < 8; ++me)
#pragma unroll
        for (int j = 0; j < 4; ++j) X[(me * 16 + g * 4 + j) * 64 + qh * 32 + ni * 16 + c16] = O[me][ni][j] * sc;
    }
  }
  __syncthreads();
  if (comp == 0) {
    const float* subln = P->in[13];
#pragma unroll
    for (int ni = 0; ni < 2; ++ni) {
      float il = 1.f / l[ni], ss = 0.f;
#pragma unroll
      for (int me = 0; me < 8; ++me)
#pragma unroll
        for (int j = 0; j < 4; ++j) {
          float v = O[me][ni][j] * il - X[(me * 16 + g * 4 + j) * 64 + qh * 32 + ni * 16 + c16];
          O[me][ni][j] = v; ss += v * v;
        }
      ss += __shfl_xor(ss, 16); ss += __shfl_xor(ss, 32);
      float r = rsqrtf(ss * (1.f / 128.f) + 1e-6f) * 0.8f;
      size_t row = (size_t)(b * T_ + tq0 + ni * 16 + c16) * DM + h * 128;
#pragma unroll
      for (int me = 0; me < 8; ++me) {
        int e = me * 16 + g * 4;
        float4 w = *reinterpret_cast<const float4*>(subln + e);
        *reinterpret_cast<uint2*>(mix + row + e) =
            pack4(O[me][ni][0] * r * w.x, O[me][ni][1] * r * w.y, O[me][ni][2] * r * w.z, O[me][ni][3] * r * w.w);
      }
    }
  }
  __syncthreads();
}

__device__ __forceinline__ float red8(float x) { x = red4(x); x += dppf<0x141>(x); return x; }

template <int MODE>
__device__ __forceinline__ void rwkv_work(KP P, int chain, int half, int tbeg, int tend, unsigned char* sm) {
  constexpr int CH = 32;
  constexpr int NIT = (MODE == 0) ? 5 : 7;
  const int tid = tidx(), lane = tid & 63, wid = tid >> 6, c16 = lane & 15, g = lane >> 4;
  const int b = chain >> 3, h = chain & 7;
  const bf16_t* p = reinterpret_cast<const bf16_t*>(P->ws + OFF_B) + (size_t)b * T_ * LDAB;
  bf16_t* mix = reinterpret_cast<bf16_t*>(P->ws + OFF_A);
  float* ybuf = reinterpret_cast<float*>(P->ws + OFF_Y);
  float* xr = reinterpret_cast<float*>(sm);
  float* xk = xr + CH * 64;
  float* xv = xk + CH * 64;
  float* dec = xv + CH * 64;
  float* av = (MODE == 0) ? dec + CH * 64 : xv + CH * 64;
  float* kkv = av + CH * 64;
  float* gv = av + CH * 64;
  unsigned char* twl = sm + 49152;
  unsigned char* xal = (MODE == 0) ? sm + 53248 : sm + 40960;
  unsigned char* sgl = sm + 45056;
  float* mus = reinterpret_cast<float*>(sm + 57344);
  float* bonus = mus + 448;
  float* cst = bonus + CH;
  float* sc2 = cst + 448;
  for (int i = tid; i < 448; i += NTHR) {
    int a = i >> 6, n = h * 64 + (i & 63);
    const float* src = (a == 0) ? P->in[15] : (a == 1) ? P->in[17] : (a == 2) ? P->in[20] : (a == 3) ? P->in[21] : (a == 4) ? P->in[22] : (a == 5) ? P->in[23] : P->in[24];
    cst[i] = src[n];
  }
  for (int i = tid; i < 448; i += NTHR) {
    int ch = i >> 3, e = i & 7;
    int col = (ch < 24) ? ((ch >> 3) * 512 + h * 64 + (ch & 7) * 8) : (1536 + (ch - 24) * 8);
    mus[i] = P->in[14][col + e];
  }
  bf16x8 w2f[2], a2f[2], g2f[4];
  {
    const float* w2 = P->in[16]; const float* a2 = P->in[18]; const float* g2 = P->in[19];
    int n = h * 64 + wid * 16 + c16;
#pragma unroll
    for (int ks = 0; ks < 2; ++ks)
#pragma unroll
      for (int jj = 0; jj < 8; ++jj) {
        int k = ks * 32 + g * 8 + jj;
        if (MODE == 0) w2f[ks][jj] = (short)f2bf(w2[k * 512 + n]);
        a2f[ks][jj] = (short)f2bf(a2[k * 512 + n]);
      }
    if (MODE == 1) {
#pragma unroll
      for (int ks = 0; ks < 4; ++ks)
#pragma unroll
        for (int jj = 0; jj < 8; ++jj) g2f[ks][jj] = (short)f2bf(g2[(ks * 32 + g * 8 + jj) * 512 + n]);
    }
  }
  const int tokc = tid >> 4, colc = (tid & 15) * 4;
  const int vrow = half * 16 + (tid >> 4), kq = tid & 15;
  f32x2 S2[2];
#pragma unroll
  for (int i = 0; i < 2; ++i) S2[i] = f32x2{0.f, 0.f};
  __syncthreads();
  const int wuu = __builtin_amdgcn_readfirstlane(wid);
  uint4 rcu[NIT], rpu[NIT];
  auto item_of = [&](int it, int& tok, int& ch) -> int {
    int sl = it * 4 + wuu;
    if (MODE == 1 && sl >= 12) sl += 4;
    if (sl < 12) { int j = sl * 64 + lane; tok = j / 24; ch = j - tok * 24; return 0; }
    if (sl < 16) { int j = (sl - 12) * 64 + lane; tok = j >> 3; ch = 24 + (j & 7); return 1; }
    if (sl < 20) { int j = (sl - 16) * 64 + lane; tok = j >> 3; ch = 32 + (j & 7); return 2; }
    if (MODE == 1 && sl < 28) { int j = (sl - 20) * 64 + lane; tok = j >> 4; ch = 40 + (j & 15); return 3; }
    tok = 0; ch = 0; return -1;
  };
  auto issue_a = [&](int t0n) {
#pragma unroll
    for (int it = 0; it < NIT; ++it) {
      int tok, ch;
      int ty = item_of(it, tok, ch);
      rcu[it] = make_uint4(0, 0, 0, 0); rpu[it] = make_uint4(0, 0, 0, 0);
      if (ty >= 0) {
        int col = 1536 + ((ch < 24) ? ((ch >> 3) * 512 + h * 64 + (ch & 7) * 8) : (1536 + (ch - 24) * 8));
        int t = t0n + tok;
        rcu[it] = *reinterpret_cast<const uint4*>(p + (size_t)t * LDAB + col);
        if (t > 0) rpu[it] = *reinterpret_cast<const uint4*>(p + (size_t)(t - 1) * LDAB + col);
      }
    }
  };
  issue_a(tbeg);
  for (int t0 = tbeg; t0 < tend; t0 += CH) {
#pragma unroll
    for (int it = 0; it < NIT; ++it) {
      int tok, ch;
      int ty = item_of(it, tok, ch);
      if (ty >= 0) {
        uint4 cu = rcu[it], pu = rpu[it];
        const unsigned cw[4] = {cu.x, cu.y, cu.z, cu.w}, pw[4] = {pu.x, pu.y, pu.z, pu.w};
        float xm[8];
#pragma unroll
        for (int e = 0; e < 8; ++e) {
          float c = bf2f((unsigned short)(cw[e >> 1] >> ((e & 1) * 16)));
          float q = bf2f((unsigned short)(pw[e >> 1] >> ((e & 1) * 16)));
          xm[e] = c + (q - c) * mus[ch * 8 + e];
        }
        if (ty == 0) {
          float* d = xr + (ch >> 3) * (CH * 64) + tok * 64 + (ch & 7) * 8;
          *reinterpret_cast<float4*>(d) = make_float4(xm[0], xm[1], xm[2], xm[3]);
          *reinterpret_cast<float4*>(d + 4) = make_float4(xm[4], xm[5], xm[6], xm[7]);
        } else {
          unsigned char* d;
          if (ty == 1) { d = twl + swz(tok, ch - 24);
#pragma unroll
            for (int e = 0; e < 8; ++e) xm[e] = ftanhf_(xm[e]); }
          else if (ty == 2) d = xal + swz(tok, ch - 32);
          else { d = sgl + ((ch - 40) >> 3) * 4096 + swz(tok, (ch - 40) & 7);
#pragma unroll
            for (int e = 0; e < 8; ++e) xm[e] = sigmoidf_(xm[e]); }
          *reinterpret_cast<uint4*>(d) = make_uint4(pack2(xm[0], xm[1]), pack2(xm[2], xm[3]), pack2(xm[4], xm[5]), pack2(xm[6], xm[7]));
        }
      }
    }
    if (t0 + CH < tend) issue_a(t0 + CH);
    __syncthreads();
#pragma unroll
    for (int nt = 0; nt < 2; ++nt) {
      f32x4 aw = {0.f, 0.f, 0.f, 0.f}, aa = {0.f, 0.f, 0.f, 0.f}, ag = {0.f, 0.f, 0.f, 0.f};
#pragma unroll
      for (int ks = 0; ks < 2; ++ks) {
        if (MODE == 0) aw = MFMA(w2f[ks], ldsfrag(twl, nt * 16 + c16, ks * 4 + g), aw);
        aa = MFMA(a2f[ks], ldsfrag(xal, nt * 16 + c16, ks * 4 + g), aa);
      }
      if (MODE == 1) {
#pragma unroll
        for (int ks = 0; ks < 4; ++ks) ag = MFMA(g2f[ks], ldsfrag(sgl + (ks >> 1) * 4096, nt * 16 + c16, (ks & 1) * 4 + g), ag);
      }
      float dv[4], a4[4];
      const float4 w04 = *reinterpret_cast<const float4*>(cst + wid * 16 + g * 4);
      const float4 a04 = *reinterpret_cast<const float4*>(cst + 64 + wid * 16 + g * 4);
      const float w0c[4] = {w04.x, w04.y, w04.z, w04.w}, a0c[4] = {a04.x, a04.y, a04.z, a04.w};
#pragma unroll
      for (int j = 0; j < 4; ++j) {
        if (MODE == 0) {
          float wv = w0c[j] + aw[j];
          float w = -__logf(1.f + __expf(-wv)) - 0.5f;
          dv[j] = __expf(-__expf(w));
        }
        a4[j] = sigmoidf_(a0c[j] + aa[j]);
      }
      int o = (nt * 16 + c16) * 64 + wid * 16 + g * 4;
      if (MODE == 0) *reinterpret_cast<float4*>(dec + o) = make_float4(dv[0], dv[1], dv[2], dv[3]);
      *reinterpret_cast<float4*>(av + o) = make_float4(a4[0], a4[1], a4[2], a4[3]);
      if (MODE == 1) *reinterpret_cast<float4*>(gv + o) = make_float4(ag[0], ag[1], ag[2], ag[3]);
    }
    __syncthreads();
#pragma unroll
    for (int tt = 0; tt < 2; ++tt) {
      const int tk = tokc + tt * 16;
      int o = tk * 64 + colc;
      float4 k4 = *reinterpret_cast<float4*>(xk + o), a4 = *reinterpret_cast<float4*>(av + o), r4 = *reinterpret_cast<float4*>(xr + o);
      float k[4] = {k4.x, k4.y, k4.z, k4.w}, a[4] = {a4.x, a4.y, a4.z, a4.w}, r[4] = {r4.x, r4.y, r4.z, r4.w};
      const float4 c0 = *reinterpret_cast<const float4*>(cst + 128 + colc);
      const float4 c1 = *reinterpret_cast<const float4*>(cst + 192 + colc);
      const float4 c2 = *reinterpret_cast<const float4*>(cst + 256 + colc);
      const float kkc[4] = {c0.x, c0.y, c0.z, c0.w}, kac[4] = {c1.x, c1.y, c1.z, c1.w}, rkc[4] = {c2.x, c2.y, c2.z, c2.w};
      float kk[4], kp[4], ss = 0.f, bs = 0.f;
#pragma unroll
      for (int i = 0; i < 4; ++i) {
        kk[i] = k[i] * kkc[i]; ss += kk[i] * kk[i];
        kp[i] = k[i] * (1.f + (a[i] - 1.f) * kac[i]);
        bs += r[i] * kp[i] * rkc[i];
      }
      if (MODE == 1) {
        bs = red16(bs);
        if ((tid & 15) == 0) bonus[tk] = bs;
      } else {
        ss = red16(ss);
        float rn = rsqrtf(ss + 1e-12f);
        float4 d4 = *reinterpret_cast<float4*>(dec + o);
        const float dd[4] = {d4.x, d4.y, d4.z, d4.w};
        float brs = 0.f, krs = 0.f, bv4[4];
#pragma unroll
        for (int i = 0; i < 4; ++i) { kk[i] *= rn; bv4[i] = kk[i] * a[i]; brs += bv4[i] * r[i]; krs += kp[i] * r[i]; }
        brs = red16(brs); krs = red16(krs);
        *reinterpret_cast<float4*>(kkv + o) = make_float4(kk[0], kk[1], kk[2], kk[3]);
        *reinterpret_cast<float4*>(av + o) = make_float4(bv4[0], bv4[1], bv4[2], bv4[3]);
        *reinterpret_cast<float4*>(xk + o) = make_float4(kp[0], kp[1], kp[2], kp[3]);
        *reinterpret_cast<float4*>(xr + o) = make_float4(dd[0] * r[0], dd[1] * r[1], dd[2] * r[2], dd[3] * r[3]);
        if ((tid & 15) == 0) { sc2[tk * 2] = brs; sc2[tk * 2 + 1] = krs; }
      }
    }
    __syncthreads();
    if (MODE == 0) {
      const int ko = kq * 4;
      f32x2 K2[2], W2[2], D2[2], P2[2], B2[2];
#define LD4(DST, SRC) { float4 t4 = *reinterpret_cast<const float4*>(SRC); DST[0] = f32x2{t4.x, t4.y}; DST[1] = f32x2{t4.z, t4.w}; }
      LD4(K2, kkv + ko) LD4(W2, xr + ko) LD4(D2, dec + ko) LD4(P2, xk + ko) LD4(B2, av + ko)
      float vv = xv[vrow];
      const float2 scl = *reinterpret_cast<const float2*>(sc2 + (lane & (CH - 1)) * 2);
      float* yout = ybuf + (size_t)(b * T_ + t0) * 512 + h * 64 + vrow;
#pragma unroll 2
      for (int t = 0; t < CH; ++t) {
        const int tn1 = (t < CH - 1 ? t + 1 : CH - 1);
        const int tn = tn1 * 64 + ko;
        float vvn = xv[tn1 * 64 + vrow];
        f32x2 sa2 = S2[0] * K2[0] + S2[1] * K2[1];
        f32x2 ya2 = S2[0] * W2[0] + S2[1] * W2[1];
        LD4(K2, kkv + tn) LD4(W2, xr + tn)
        const f32x2 vv2 = f32x2{vv, vv};
        f32x2 tmp0 = S2[0] * D2[0] + vv2 * P2[0], tmp1 = S2[1] * D2[1] + vv2 * P2[1];
        float sa = red16(sa2[0] + sa2[1]);
        float ya = red16(ya2[0] + ya2[1]);
        const f32x2 nsa2 = f32x2{-sa, -sa};
        S2[0] = tmp0 + nsa2 * B2[0]; S2[1] = tmp1 + nsa2 * B2[1];
        const float brs = __int_as_float(__builtin_amdgcn_readlane(__float_as_int(scl.x), t));
        const float krs = __int_as_float(__builtin_amdgcn_readlane(__float_as_int(scl.y), t));
        float y = ya - sa * brs + vv * krs;
        asm volatile("" : "+v"(y));
        if (kq == 0) yout[(size_t)t * 512] = y;
        LD4(D2, dec + tn) LD4(P2, xk + tn) LD4(B2, av + tn)
        asm volatile("" : "+v"(vvn));
        vv = vvn;
      }
#undef LD4
    } else {
#pragma unroll
      for (int tt = 0; tt < 2; ++tt) {
        const int tk = tokc + tt * 16;
        int o = tk * 64 + colc;
        float4 y4 = *reinterpret_cast<const float4*>(ybuf + (size_t)(b * T_ + t0 + tk) * 512 + h * 64 + colc);
        float4 v4 = *reinterpret_cast<float4*>(xv + o), g4 = *reinterpret_cast<float4*>(gv + o);
        float y[4] = {y4.x, y4.y, y4.z, y4.w}, v[4] = {v4.x, v4.y, v4.z, v4.w}, gg[4] = {g4.x, g4.y, g4.z, g4.w};
        const float4 c3 = *reinterpret_cast<const float4*>(cst + 320 + colc);
        const float4 c4 = *reinterpret_cast<const float4*>(cst + 384 + colc);
        const float lnw[4] = {c3.x, c3.y, c3.z, c3.w}, lnb[4] = {c4.x, c4.y, c4.z, c4.w};
        float s = red16(y[0] + y[1] + y[2] + y[3]);
        float mean = s * (1.f / 64.f), vs = 0.f;
#pragma unroll
        for (int i = 0; i < 4; ++i) { y[i] -= mean; vs += y[i] * y[i]; }
        vs = red16(vs);
        float rs = rsqrtf(vs * (1.f / 64.f) + 64e-5f), bn = bonus[tk];
        float ov[4];
#pragma unroll
        for (int i = 0; i < 4; ++i) ov[i] = (y[i] * rs * lnw[i] + lnb[i] + bn * v[i]) * gg[i];
        *reinterpret_cast<uint2*>(mix + (size_t)(b * T_ + t0 + tk) * DM + 512 + h * 64 + colc) = pack4(ov[0], ov[1], ov[2], ov[3]);
      }
    }
    __syncthreads();
  }
}

__device__ __forceinline__ void phase_mixAB(KP P, unsigned char* sm) {
  volatile int& s_item = *reinterpret_cast<volatile int*>(sm + 65532);
  if (bidx() < 256) rwkv_work<0>(P, bidx() >> 2, bidx() & 3, 0, T_, sm);
  unsigned* cnt = reinterpret_cast<unsigned*>(P->ws + OFF_MISC + 64);
  for (;;) {
    __syncthreads();
    if (tidx() == 0) s_item = (int)atomicAdd(cnt, 1u);
    __syncthreads();
    int item = s_item;
    if (item >= 2048) break;
    diffattn_item(P, item, sm);
  }
  unsigned* cnt2 = reinterpret_cast<unsigned*>(P->ws + OFF_MISC + 72);
  for (;;) {
    __syncthreads();
    if (tidx() == 0) s_item = (int)atomicAdd(cnt2, 1u);
    __syncthreads();
    int v = s_item;
    if (v >= TR_TOTAL - TR_EARLY) break;
    transpose_tile(P, tr_late_tile(v), sm);
  }
}

__device__ __forceinline__ void nsa_item(KP P, int item, unsigned char* sm) {
  const int tid = tidx(), lane = tid & 63, wid = tid >> 6, c16 = lane & 15, g = lane >> 4;
  const int qblk = 127 - (item >> 4);
  const int bg = item & 15, b = bg >> 1, gg = bg & 1;
  const int t0 = qblk * 32;
  const bf16_t* p = reinterpret_cast<const bf16_t*>(P->ws + OFF_B) + (size_t)b * T_ * LDCD;
  const bf16_t* kcmp = reinterpret_cast<const bf16_t*>(P->ws + OFF_KCMP) + (size_t)bg * 256 * 64;
  const bf16_t* vcmpT = reinterpret_cast<const bf16_t*>(P->ws + OFF_VCMPT) + (size_t)bg * 64 * 256;
  const bf16_t* vts = reinterpret_cast<const bf16_t*>(P->ws + OFF_VTS) + (size_t)bg * 64 * T_;
  const bf16_t* vtw = reinterpret_cast<const bf16_t*>(P->ws + OFF_VTW) + (size_t)bg * 64 * T_;
  bf16_t* mix = reinterpret_cast<bf16_t*>(P->ws + OFF_A);
  unsigned char* Ks = sm; unsigned char* Vs = sm + 8192;
  float* psum = reinterpret_cast<float*>(sm + 16384);
  unsigned long long* selm = reinterpret_cast<unsigned long long*>(sm + 16384 + 32768);
  unsigned long long* selu = selm + 32;
  const int hh = c16 & 3;
  int tq[2];
  bf16x8 qf[2][2];
#pragma unroll
  for (int ni = 0; ni < 2; ++ni) {
    tq[ni] = t0 + wid * 8 + ni * 4 + (c16 >> 2);
#pragma unroll
    for (int ks = 0; ks < 2; ++ks)
      qf[ni][ks] = u4frag(*reinterpret_cast<const uint4*>(p + (size_t)tq[ni] * LDCD + (gg * 4 + hh) * 64 + (ks * 4 + g) * 8));
  }
  float gate[2][3];
#pragma unroll
  for (int ni = 0; ni < 2; ++ni)
#pragma unroll
    for (int br = 0; br < 3; ++br) gate[ni][br] = sigmoidf_(bf2f(p[(size_t)tq[ni] * LDCD + 1280 + (gg * 4 + hh) * 3 + br]));
  f32x4 O[4][2];
  float m[2], l[2];
  const int ncv = min(255, t0 / 16 + 1);
  const int nct = (ncv + 63) >> 6;
  for (int i = tid; i < 32 * 256; i += NTHR) psum[i] = 0.f;
  m[0] = m[1] = -1e30f; l[0] = l[1] = 0.f;
  for (int ct = 0; ct < nct; ++ct) {
    __syncthreads();
    load_tile(Ks, kcmp + (size_t)ct * 64 * 64, 64, 64);
    __syncthreads();
    f32x4 S[4][2];
#pragma unroll
    for (int mi = 0; mi < 4; ++mi) {
      S[mi][0] = f32x4{0.f, 0.f, 0.f, 0.f}; S[mi][1] = f32x4{0.f, 0.f, 0.f, 0.f};
#pragma unroll
      for (int ks = 0; ks < 2; ++ks) {
        bf16x8 kf = ldsfrag(Ks, mi * 16 + c16, ks * 4 + g);
        S[mi][0] = MFMA(kf, qf[0][ks], S[mi][0]);
        S[mi][1] = MFMA(kf, qf[1][ks], S[mi][1]);
      }
    }
#pragma unroll
    for (int ni = 0; ni < 2; ++ni) {
      float mx = -1e30f;
#pragma unroll
      for (int mi = 0; mi < 4; ++mi)
#pragma unroll
        for (int j = 0; j < 4; ++j) {
          int n = ct * 64 + mi * 16 + g * 4 + j;
          bool ok = (n < 255) && (16 * n + 31 <= tq[ni]);
          if (!ok) S[mi][ni][j] = -1e30f;
          mx = fmaxf(mx, S[mi][ni][j]);
        }
      mx = fmaxf(mx, __shfl_xor(mx, 16)); mx = fmaxf(mx, __shfl_xor(mx, 32));
      float mn = fmaxf(m[ni], mx);
      float rs = 0.f;
#pragma unroll
      for (int mi = 0; mi < 4; ++mi)
#pragma unroll
        for (int j = 0; j < 4; ++j) { float s = S[mi][ni][j]; rs += (s > -1e29f) ? ex2(s - mn) : 0.f; }
      l[ni] = l[ni] * ex2(m[ni] - mn) + rs;
      m[ni] = mn;
    }
  }
  float il[2];
#pragma unroll
  for (int ni = 0; ni < 2; ++ni) {
    l[ni] += __shfl_xor(l[ni], 16); l[ni] += __shfl_xor(l[ni], 32);
    il[ni] = (l[ni] > 0.f) ? 1.f / l[ni] : 0.f;
  }
#pragma unroll
  for (int i = 0; i < 4; ++i) { O[i][0] = f32x4{0.f, 0.f, 0.f, 0.f}; O[i][1] = f32x4{0.f, 0.f, 0.f, 0.f}; }
  for (int ct = 0; ct < nct; ++ct) {
    __syncthreads();
    load_tile(Ks, kcmp + (size_t)ct * 64 * 64, 64, 64);
    load_tile(Vs, vcmpT + ct * 64, 256, 64);
    __syncthreads();
    f32x4 S[4][2];
#pragma unroll
    for (int mi = 0; mi < 4; ++mi) {
      S[mi][0] = f32x4{0.f, 0.f, 0.f, 0.f}; S[mi][1] = f32x4{0.f, 0.f, 0.f, 0.f};
#pragma unroll
      for (int ks = 0; ks < 2; ++ks) {
        bf16x8 kf = ldsfrag(Ks, mi * 16 + c16, ks * 4 + g);
        S[mi][0] = MFMA(kf, qf[0][ks], S[mi][0]);
        S[mi][1] = MFMA(kf, qf[1][ks], S[mi][1]);
      }
    }
#pragma unroll
    for (int ni = 0; ni < 2; ++ni)
#pragma unroll
      for (int mi = 0; mi < 4; ++mi)
#pragma unroll
        for (int j = 0; j < 4; ++j) {
          int n = ct * 64 + mi * 16 + g * 4 + j;
          bool ok = (n < 255) && (16 * n + 31 <= tq[ni]);
          float pv = ok ? ex2(S[mi][ni][j] - m[ni]) * il[ni] : 0.f;
          S[mi][ni][j] = pv;
          float hs = red4(pv);
          if (hh == 0) psum[(wid * 8 + ni * 4 + (c16 >> 2)) * 256 + n] = hs;
        }
    bf16x8 pf[2][2];
#pragma unroll
    for (int ni = 0; ni < 2; ++ni) { pf[ni][0] = packfrag(S[0][ni], S[1][ni]); pf[ni][1] = packfrag(S[2][ni], S[3][ni]); }
#pragma unroll
    for (int me = 0; me < 4; ++me)
#pragma unroll
      for (int s = 0; s < 2; ++s) {
        bf16x8 vf = ldsfragP(Vs, me * 16 + c16, s, g);
        O[me][0] = MFMA(vf, pf[0][s], O[me][0]);
        O[me][1] = MFMA(vf, pf[1][s], O[me][1]);
      }
  }
#pragma unroll
  for (int ni = 0; ni < 2; ++ni)
#pragma unroll
    for (int me = 0; me < 4; ++me)
#pragma unroll
      for (int j = 0; j < 4; ++j) O[me][ni][j] *= gate[ni][0];
  __syncthreads();
  {
    unsigned long long un = 0ull;
    float* scw = reinterpret_cast<float*>(selu + 4) + wid * 64;
#pragma unroll 1
    for (int qi = 0; qi < 8; ++qi) {
      int q = wid * 8 + qi, t = t0 + q, j = lane;
      float4 a = *reinterpret_cast<const float4*>(psum + q * 256 + 4 * j);
      float imp = a.x + a.y + a.z + 0.5f * a.w;
      if (j > 0) imp += 0.5f * psum[q * 256 + 4 * j - 1];
      int cur = t >> 6;
      bool forced = (j == 0) || (j == cur) || (j == cur - 1);
      bool vld = (j * 64 <= t);
      float score = vld ? (imp + (forced ? 1e4f : 0.f)) : -1e30f;
      int rank = 0;
      scw[lane] = score;
      __builtin_amdgcn_fence(__ATOMIC_RELEASE, "wavefront");
      __builtin_amdgcn_wave_barrier();
      __builtin_amdgcn_fence(__ATOMIC_ACQUIRE, "wavefront");
#pragma unroll 4
      for (int i4 = 0; i4 < 16; ++i4) {
        float4 o = *reinterpret_cast<const float4*>(scw + i4 * 4);
        int i = i4 * 4;
        rank += (o.x > score || (o.x == score && i < j)) ? 1 : 0;
        rank += (o.y > score || (o.y == score && i + 1 < j)) ? 1 : 0;
        rank += (o.z > score || (o.z == score && i + 2 < j)) ? 1 : 0;
        rank += (o.w > score || (o.w == score && i + 3 < j)) ? 1 : 0;
      }
      __builtin_amdgcn_wave_barrier();
      unsigned long long mk = __ballot(rank < 16);
      if (lane == 0) selm[q] = mk;
      un |= mk;
    }
    if (lane == 0) selu[wid] = un;
  }
  __syncthreads();
  const unsigned long long uni = selu[0] | selu[1] | selu[2] | selu[3];
  f32x4* OUTL = reinterpret_cast<f32x4*>(psum) + tid;
#pragma unroll
  for (int ni = 0; ni < 2; ++ni)
#pragma unroll
    for (int me = 0; me < 4; ++me) OUTL[(me * 2 + ni) * 256] = O[me][ni];
  unsigned long long msk[2];
#pragma unroll
  for (int ni = 0; ni < 2; ++ni) {
    msk[ni] = selm[wid * 8 + ni * 4 + (c16 >> 2)];
    unsigned mlo = (unsigned)(msk[ni] & 0xffffffffull), mhi = (unsigned)(msk[ni] >> 32);
    asm volatile("" : "+v"(mlo), "+v"(mhi));
    msk[ni] = ((unsigned long long)mhi << 32) | mlo;
  }
  unsigned uni_lo = (unsigned)(uni & 0xffffffffull), uni_hi = (unsigned)(uni >> 32);
  asm volatile("" : "+v"(uni_lo), "+v"(uni_hi));
  unsigned char* const stg[2] = {sm, sm + 49152};
  const int jhi = t0 >> 6;
  {
#pragma unroll
    for (int i = 0; i < 4; ++i) { O[i][0] = f32x4{0.f, 0.f, 0.f, 0.f}; O[i][1] = f32x4{0.f, 0.f, 0.f, 0.f}; }
    m[0] = m[1] = 0.f; l[0] = l[1] = 0.f;
    load_tile_dma(stg[0], p + 768 + gg * 64, LDCD, 64);
    load_tile_dma(stg[0] + 8192, vts, T_, 64);
    asm volatile("s_waitcnt vmcnt(0)" ::: "memory");
    __syncthreads();
    for (int jb = 0; jb <= jhi; ++jb) {
      const int st = jb & 1;
      if (jb < jhi) {
        load_tile_dma(stg[st ^ 1], p + (size_t)((jb + 1) * 64) * LDCD + 768 + gg * 64, LDCD, 64);
        load_tile_dma(stg[st ^ 1] + 8192, vts + (jb + 1) * 64, T_, 64);
      }
      const int kbase = jb * 64;
      const bool sel0 = (msk[0] >> jb) & 1ull, sel1 = (msk[1] >> jb) & 1ull;
      if (jb == jhi) {
        flash_tile<4>(O, m, l, qf, stg[st], stg[st] + 8192, true, jb == 0, lane,
                      [&](int key, int ni) { return (ni ? sel1 : sel0) && (kbase + key <= tq[ni]); });
      } else {
        const bool allsel = __all(sel0 && sel1);
        flash_tile<4>(O, m, l, qf, stg[st], stg[st] + 8192, !allsel, jb == 0, lane,
                      [&](int key, int ni) { return ni ? sel1 : sel0; });
      }
      asm volatile("s_waitcnt vmcnt(0)" ::: "memory");
      __syncthreads();
    }
#pragma unroll
    for (int ni = 0; ni < 2; ++ni) {
      l[ni] += __shfl_xor(l[ni], 16); l[ni] += __shfl_xor(l[ni], 32);
      float sc = (l[ni] > 0.f) ? gate[ni][1] / l[ni] : 0.f;
#pragma unroll
      for (int me = 0; me < 4; ++me) {
        f32x4 a = OUTL[(me * 2 + ni) * 256];
#pragma unroll
        for (int j = 0; j < 4; ++j) a[j] += sc * O[me][ni][j];
        OUTL[(me * 2 + ni) * 256] = a;
      }
    }
  }
  {
#pragma unroll
    for (int i = 0; i < 4; ++i) { O[i][0] = f32x4{0.f, 0.f, 0.f, 0.f}; O[i][1] = f32x4{0.f, 0.f, 0.f, 0.f}; }
    m[0] = m[1] = 0.f; l[0] = l[1] = 0.f;
    const int jlo = max(0, t0 - 511) >> 6;
    load_tile_dma(stg[0], p + (size_t)(jlo * 64) * LDCD + 1024 + gg * 64, LDCD, 64);
    load_tile_dma(stg[0] + 8192, vtw + jlo * 64, T_, 64);
    asm volatile("s_waitcnt vmcnt(0)" ::: "memory");
    __syncthreads();
    for (int jb = jlo; jb <= jhi; ++jb) {
      const int st = (jb - jlo) & 1;
      if (jb < jhi) {
        load_tile_dma(stg[st ^ 1], p + (size_t)((jb + 1) * 64) * LDCD + 1024 + gg * 64, LDCD, 64);
        load_tile_dma(stg[st ^ 1] + 8192, vtw + (jb + 1) * 64, T_, 64);
      }
      const int kbase = jb * 64;
      const bool edge = (jb == jhi) || (kbase <= t0 + 31 - 512);
      flash_tile<4>(O, m, l, qf, stg[st], stg[st] + 8192, edge, jb == jlo, lane,
                    [&](int key, int ni) { int kp = kbase + key; return (kp <= tq[ni]) && (kp > tq[ni] - 512); });
      asm volatile("s_waitcnt vmcnt(0)" ::: "memory");
      __syncthreads();
    }
#pragma unroll
    for (int ni = 0; ni < 2; ++ni) {
      l[ni] += __shfl_xor(l[ni], 16); l[ni] += __shfl_xor(l[ni], 32);
      float sc = (l[ni] > 0.f) ? gate[ni][2] / l[ni] : 0.f;
#pragma unroll
      for (int me = 0; me < 4; ++me) {
        f32x4 a = OUTL[(me * 2 + ni) * 256];
#pragma unroll
        for (int j = 0; j < 4; ++j) O[me][ni][j] = a[j] + sc * O[me][ni][j];
      }
    }
  }
#pragma unroll
  for (int ni = 0; ni < 2; ++ni)
#pragma unroll
    for (int me = 0; me < 4; ++me)
      *reinterpret_cast<uint2*>(mix + (size_t)(b * T_ + tq[ni]) * DM + (gg * 4 + hh) * 64 + me * 16 + g * 4) =
          pack4(O[me][ni][0], O[me][ni][1], O[me][ni][2], O[me][ni][3]);
  __syncthreads();
}

__device__ __forceinline__ void mlstm_chain(KP P, int chain, int eh, unsigned char* sm) {
  const int tid = tidx(), lane = tid & 63, wid = tid >> 6, c16 = lane & 15, g = lane >> 4;
  const int b = chain >> 2, h = chain & 3;
  const bf16_t* p = reinterpret_cast<const bf16_t*>(P->ws + OFF_B) + (size_t)b * T_ * LDCD;
  float* hbuf = reinterpret_cast<float*>(P->ws + OFF_Y);
  const int Q0 = 1304 + h * 64, K0 = 1560 + h * 64, V0 = 1816 + h * 128 + eh * 64, I0 = 2328 + h, F0 = 2332 + h;
  unsigned char* qs = sm;
  unsigned char* ks_ = sm + 8192;
  unsigned char* kTw = sm + 16384;
  unsigned char* vTa = sm + 24576;
  unsigned char* Cs = vTa + 10240;
  float* fa = reinterpret_cast<float*>(Cs + 10240);
  float* bcum = fa; float* aarr = fa + 64; float* msv = fa + 128; float* cwv = fa + 192;
  unsigned char* rawq = sm + 46592;
  unsigned char* rawk = rawq + 8704;
  const float* convw = P->in[33]; const float* convb = P->in[34];
  const float igb = P->in[35][h], fgb = P->in[36][h];
  typedef __attribute__((address_space(3))) unsigned* ldsp_t;
  auto issue_raw = [&](int tq) {
    for (int i = tid; i < 67 * 8; i += NTHR) {
      int r = i >> 3, c = (i & 7) ^ (r & 7);
      int tk = max(tq - 3 + r, 0);
      __builtin_amdgcn_global_load_lds((const unsigned*)(p + (size_t)tk * LDCD + Q0 + c * 8), (ldsp_t)(rawq + i * 16), 16, 0, 0);
      __builtin_amdgcn_global_load_lds((const unsigned*)(p + (size_t)tk * LDCD + K0 + c * 8), (ldsp_t)(rawk + i * 16), 16, 0, 0);
    }
  };
  for (int i = tid; i < 10240 / 4; i += NTHR) reinterpret_cast<unsigned*>(Cs)[i] = 0u;
  for (int i = tid; i < 16 * 64; i += NTHR) {
    int r = 64 + (i >> 6), c = i & 63;
    *reinterpret_cast<bf16_t*>(vTa + swz(r, c >> 3) + (c & 7) * 2) = (r == 64) ? (bf16_t)0x3f80 : (bf16_t)0;
  }
  f32x4 Cst[5];
#pragma unroll
  for (int i = 0; i < 5; ++i) Cst[i] = f32x4{0.f, 0.f, 0.f, 0.f};
  float mrun = 0.f;
  bf16_t gi_raw = p[(size_t)lane * LDCD + I0], gf_raw = p[(size_t)lane * LDCD + F0];
  const int wu = __builtin_amdgcn_readfirstlane(wid);
  uint4 vraw[2];
  {
    const bf16_t* vr0 = p + (size_t)lane * LDCD + V0 + wu * 16;
    vraw[0] = *reinterpret_cast<const uint4*>(vr0); vraw[1] = *reinterpret_cast<const uint4*>(vr0 + 8);
  }
  issue_raw(0);
  asm volatile("s_waitcnt vmcnt(0)" ::: "memory");
  if (tid < 24) {
    *reinterpret_cast<uint4*>(rawq + tid * 16) = make_uint4(0, 0, 0, 0);
    *reinterpret_cast<uint4*>(rawk + tid * 16) = make_uint4(0, 0, 0, 0);
  }
  __syncthreads();
  for (int t0 = 0; t0 < T_; t0 += 64) {
    float wr, dcy, mnew;
    {
      float li = bf2f(gi_raw) + igb;
      float lf = -softplusf_(-(bf2f(gf_raw) + fgb));
      float bc = wave_scan_add(lf);
      float a = li - bc;
      float pm = wave_scan_max(a);
      float ms = bc + fmaxf(mrun, pm);
      float cw = __expf(bc + mrun - ms);
      float blast = __int_as_float(__builtin_amdgcn_readlane(__float_as_int(bc), 63));
      float amax = __int_as_float(__builtin_amdgcn_readlane(__float_as_int(pm), 63));
      mnew = blast + fmaxf(mrun, amax);
      dcy = __expf(blast + mrun - mnew);
      wr = __expf(blast + a - mnew);
      if (wid == 0) { bcum[lane] = bc; aarr[lane] = a; msv[lane] = ms; cwv[lane] = cw; }
    }
    {
      const int r = lane;
#pragma unroll 1
      for (int which = 0; which < 2; ++which) {
        const unsigned char* raw = which ? rawk : rawq;
        const int chb = which * 256 + h * 64 + wu * 16;
        float qa[16];
#pragma unroll
        for (int i = 0; i < 16; ++i) qa[i] = convb[chb + i];
#pragma unroll
        for (int jj = 0; jj < 4; ++jj) {
          const int ri = r + jj;
          uint4 q0 = *reinterpret_cast<const uint4*>(raw + swz(ri, wu * 2)), q1 = *reinterpret_cast<const uint4*>(raw + swz(ri, wu * 2 + 1));
          const unsigned qw[8] = {q0.x, q0.y, q0.z, q0.w, q1.x, q1.y, q1.z, q1.w};
#pragma unroll
          for (int i = 0; i < 16; ++i)
            qa[i] += bf2f((unsigned short)(qw[i >> 1] >> ((i & 1) * 16))) * convw[jj * 512 + chb + i];
        }
        const float sc = which ? 1.f : 0.125f;
#pragma unroll
        for (int i = 0; i < 16; ++i) qa[i] = qa[i] * sigmoidf_(qa[i]) * sc;
        unsigned char* dstt = which ? ks_ : qs;
#pragma unroll
        for (int c = 0; c < 2; ++c)
          *reinterpret_cast<uint4*>(dstt + swz(r, wu * 2 + c)) = make_uint4(pack2(qa[c * 8], qa[c * 8 + 1]), pack2(qa[c * 8 + 2], qa[c * 8 + 3]),
                                                                         pack2(qa[c * 8 + 4], qa[c * 8 + 5]), pack2(qa[c * 8 + 6], qa[c * 8 + 7]));
        if (which) {
#pragma unroll
          for (int i = 0; i < 16; ++i) {
            int d = wu * 16 + i;
            *reinterpret_cast<bf16_t*>(kTw + swz(d, r >> 3) + (r & 7) * 2) = f2bf(qa[i] * wr);
          }
        }
      }
#pragma unroll
      for (int c = 0; c < 2; ++c) {
        const unsigned vw[4] = {vraw[c].x, vraw[c].y, vraw[c].z, vraw[c].w};
#pragma unroll
        for (int i = 0; i < 8; ++i) {
          int e = wu * 16 + c * 8 + i;
          *reinterpret_cast<bf16_t*>(vTa + swz(e, r >> 3) + (r & 7) * 2) = (bf16_t)(vw[i >> 1] >> ((i & 1) * 16));
        }
      }
    }
    __syncthreads();
    if (t0 + 64 < T_) {
      issue_raw(t0 + 64);
      const bf16_t* pr = p + (size_t)(t0 + 64 + lane) * LDCD;
      gi_raw = pr[I0]; gf_raw = pr[F0];
      vraw[0] = *reinterpret_cast<const uint4*>(pr + V0 + wu * 16); vraw[1] = *reinterpret_cast<const uint4*>(pr + V0 + wu * 16 + 8);
    }
    {
      const int s = wu * 16 + c16;
      bf16x8 qf[2] = {ldsfrag(qs, s, g), ldsfrag(qs, s, 4 + g)};
      f32x4 S[4];
#pragma unroll
      for (int mi = 0; mi < 4; ++mi) {
        S[mi] = f32x4{0.f, 0.f, 0.f, 0.f};
        if (mi <= wu) {
          S[mi] = MFMA(ldsfrag(ks_, mi * 16 + c16, g), qf[0], S[mi]);
          S[mi] = MFMA(ldsfrag(ks_, mi * 16 + c16, 4 + g), qf[1], S[mi]);
        }
      }
      const float bs = bcum[s], mss = msv[s], cws = cwv[s];
#pragma unroll
      for (int mi = 0; mi < 4; ++mi)
#pragma unroll
        for (int j = 0; j < 4; ++j) {
          int r = mi * 16 + g * 4 + j;
          float wgt = __expf((r <= s) ? (bs + aarr[r] - mss) : -100.f);
          S[mi][j] *= wgt;
        }
      bf16x8 pf[2] = {packfrag(S[0], S[1]), packfrag(S[2], S[3])};
      f32x4 acc[5];
#pragma unroll
      for (int me = 0; me < 5; ++me) {
        acc[me] = f32x4{0.f, 0.f, 0.f, 0.f};
        acc[me] = MFMA(ldsfrag(Cs, me * 16 + c16, g), qf[0], acc[me]);
        acc[me] = MFMA(ldsfrag(Cs, me * 16 + c16, 4 + g), qf[1], acc[me]);
        acc[me][0] *= cws; acc[me][1] *= cws; acc[me][2] *= cws; acc[me][3] *= cws;
        acc[me] = MFMA(ldsfragP(vTa, me * 16 + c16, 0, g), pf[0], acc[me]);
        if (wu >= 2) acc[me] = MFMA(ldsfragP(vTa, me * 16 + c16, 1, g), pf[1], acc[me]);
      }
      float den = __shfl(acc[4][0], c16);
      float hd = 1.f / fmaxf(fabsf(den), __expf(-mss));
      float* hrow = hbuf + (size_t)(b * T_ + t0 + s) * 512 + h * 128 + eh * 64;
#pragma unroll
      for (int me = 0; me < 4; ++me)
        *reinterpret_cast<float4*>(hrow + me * 16 + g * 4) = make_float4(acc[me][0] * hd, acc[me][1] * hd, acc[me][2] * hd, acc[me][3] * hd);
    }
    {
      bf16x8 kf0 = ldsfragP(kTw, wu * 16 + c16, 0, g), kf1 = ldsfragP(kTw, wu * 16 + c16, 1, g);
#pragma unroll
      for (int me = 0; me < 5; ++me) {
        Cst[me][0] *= dcy; Cst[me][1] *= dcy; Cst[me][2] *= dcy; Cst[me][3] *= dcy;
        Cst[me] = MFMA(ldsfragP(vTa, me * 16 + c16, 0, g), kf0, Cst[me]);
        Cst[me] = MFMA(ldsfragP(vTa, me * 16 + c16, 1, g), kf1, Cst[me]);
      }
    }
    mrun = mnew;
    asm volatile("s_waitcnt vmcnt(0)" ::: "memory");
    __syncthreads();
    {
      const int d = wu * 16 + c16;
#pragma unroll
      for (int me = 0; me < 5; ++me)
#pragma unroll
        for (int j = 0; j < 4; ++j) {
          int e = me * 16 + g * 4 + j;
          *reinterpret_cast<bf16_t*>(Cs + swz(e, d >> 3) + (d & 7) * 2) = f2bf(Cst[me][j]);
        }
    }
  }
  __syncthreads();
}

__device__ __forceinline__ void phase_mlstm_post(KP P) {
  const int tid = tidx(), lane = tid & 63, wid = tid >> 6;
  const float* hbuf = reinterpret_cast<const float*>(P->ws + OFF_Y);
  const bf16_t* pb = reinterpret_cast<const bf16_t*>(P->ws + OFF_B);
  bf16_t* mix = reinterpret_cast<bf16_t*>(P->ws + OFF_A);
  const float* normw = P->in[37];
  for (int task = bidx() * 4 + wid; task < MTOK * 4; task += gridDim.x * 4) {
    const int tok = task >> 2, h = task & 3;
    float2 hv = *reinterpret_cast<const float2*>(hbuf + (size_t)tok * 512 + h * 128 + lane * 2);
    unsigned ogu = *reinterpret_cast<const unsigned*>(pb + (size_t)tok * LDCD + 2336 + h * 128 + lane * 2);
    float2 nw = *reinterpret_cast<const float2*>(normw + h * 128 + lane * 2);
    float ss = hv.x * hv.x + hv.y * hv.y;
    for (int o = 32; o; o >>= 1) ss += __shfl_xor(ss, o);
    float rn = rsqrtf(ss * (1.f / 128.f) + 1e-6f);
    float o0 = hv.x * rn * nw.x * sigmoidf_(bf2f((unsigned short)(ogu & 0xffff)));
    float o1 = hv.y * rn * nw.y * sigmoidf_(bf2f((unsigned short)(ogu >> 16)));
    *reinterpret_cast<unsigned*>(mix + (size_t)tok * DM + 512 + h * 128 + lane * 2) = pack2(o0, o1);
  }
}

__device__ __forceinline__ void phase_mixCD(KP P, unsigned char* sm) {
  volatile int& s_item2 = *reinterpret_cast<volatile int*>(sm + 65532);
  if (bidx() < 64) mlstm_chain(P, bidx() >> 1, bidx() & 1, sm);
  unsigned* cnt = reinterpret_cast<unsigned*>(P->ws + OFF_MISC + 68);
  for (;;) {
    __syncthreads();
    if (tidx() == 0) s_item2 = (int)atomicAdd(cnt, 1u);
    __syncthreads();
    int item = s_item2;
    if (item >= 2048) break;
    nsa_item(P, item, sm);
  }
}


#define XB_TMO      128
#define XB_XCNT(j)  (256  + 64 * (j))
#define XB_XSUB(j)  (1280 + 64 * (j))
#define XB_XGEN(j)  (2304 + 64 * (j))
#define XB_TOP      3328
#define XB_TOPGEN   3392
#define XCD_BAR_WORDS 3456
#define XB_SPIN_CAP (1u << 22)
__device__ __forceinline__ unsigned xb_ld(unsigned* p) { return __hip_atomic_load(p, __ATOMIC_RELAXED, __HIP_MEMORY_SCOPE_AGENT); }
__device__ __forceinline__ unsigned xb_add(unsigned* p, unsigned v) { return __hip_atomic_fetch_add(p, v, __ATOMIC_RELAXED, __HIP_MEMORY_SCOPE_AGENT); }
__device__ __forceinline__ unsigned xb_xcc_id() { return (unsigned)__builtin_amdgcn_s_getreg((3 << 11) | 20) & 0xFu; }
#define XB_SPIN(cond, bar) do { unsigned _sp = 0; while (cond) { __builtin_amdgcn_s_sleep(1); \
    if ((++_sp & 255u) == 0u) { if (xb_ld(&(bar)[XB_TMO])) break; if (_sp > XB_SPIN_CAP) { atomicAdd(&(bar)[XB_TMO], 1u); break; } } } } while (0)
struct XcdBarrier { unsigned x, nloc, nx; };
__device__ __forceinline__ void xcd_barrier_complete(unsigned* bar, unsigned x, unsigned& nloc, unsigned& nx) {
  const unsigned G = gridDim.x;
  unsigned sum, cnt, mine, sp = 0u;
  for (;;) {
    sum = 0u; cnt = 0u; mine = 0u;
#pragma unroll
    for (unsigned j = 0; j < 16; ++j) { const unsigned c = xb_ld(&bar[XB_XCNT(j)]); sum += c; cnt += (c > 0u) ? 1u : 0u; mine = (j == x) ? c : mine; }
    if (sum == G) break;
    __builtin_amdgcn_s_sleep(1);
    if ((++sp & 255u) == 0u) { if (xb_ld(&bar[XB_TMO])) break; if (sp > XB_SPIN_CAP) { atomicAdd(&bar[XB_TMO], 1u); break; } }
  }
  nloc = mine > 0u ? mine : 1u; nx = cnt > 0u ? cnt : 1u;
}
__device__ __forceinline__ void xcd_barrier(XcdBarrier& b, KP kpp) {
  asm volatile("s_waitcnt vmcnt(0)" ::: "memory");
  __syncthreads();
  if (threadIdx.x == 0) {
    unsigned* bar = reinterpret_cast<unsigned*>(kp_launder(kpp)->ws + OFF_XBAR);
    __builtin_amdgcn_s_waitcnt(0);
    if (b.nloc == 0u) xcd_barrier_complete(bar, b.x, b.nloc, b.nx);
    const unsigned nloc = b.nloc, nx = b.nx;
    const unsigned old = xb_add(&bar[XB_XSUB(b.x)], 1u);
    const unsigned gen = old / nloc;
    if (old + 1u == (gen + 1u) * nloc) {
      __builtin_amdgcn_fence(__ATOMIC_RELEASE, "agent");
      asm volatile("s_waitcnt vmcnt(0)" ::: "memory");
      const unsigned og = xb_add(&bar[XB_TOP], 1u);
      const unsigned tg = og / nx;
      if (og + 1u == (tg + 1u) * nx) xb_add(&bar[XB_TOPGEN], 1u);
      else XB_SPIN(xb_ld(&bar[XB_TOPGEN]) == tg, bar);
      __builtin_amdgcn_fence(__ATOMIC_ACQUIRE, "agent");
      xb_add(&bar[XB_XGEN(b.x)], 1u);
      asm volatile("s_waitcnt vmcnt(0)" ::: "memory");
    } else {
      XB_SPIN(xb_ld(&bar[XB_XGEN(b.x)]) == gen, bar);
      __builtin_amdgcn_fence(__ATOMIC_ACQUIRE, "agent");
      asm volatile("s_waitcnt vmcnt(0)" ::: "memory");
    }
  }
  __syncthreads();
}

constexpr int NPHASE = 24;
enum { OP_RWKVPOST = 13, OP_MLSTMPOST = 14, OP_PREP = 0, OP_FNORM, OP_GATEUP, OP_DOWN, OP_MNORM, OP_WINAB, OP_MIXAB, OP_WOUT, OP_WINCD, OP_CMP1, OP_CMP2, OP_MIXCD, OP_FINAL };
template <int op>
__device__ __forceinline__ void run_op(KP P, const int f, unsigned char* sm) {
  unsigned char* ws = P->ws;
  bf16_t* xn = reinterpret_cast<bf16_t*>(ws + OFF_A);
  bf16_t* bufB = reinterpret_cast<bf16_t*>(ws + OFF_B);
  const float2* rope = reinterpret_cast<const float2*>(ws + OFF_ROPE);
  float* xres = P->out;
  switch (op) {
    case OP_PREP: phase_prep(P, sm); break;
    case OP_FNORM: {
      int layer = f >> 1; bool bsel = f & 1;
      const float* src = (f == 0) ? P->in[0] : xres;
      phase_rmsnorm(src, (bsel ? P->in[6] : P->in[1]) + layer * DM, xn);
    } break;
    case OP_GATEUP: {
      ALoadPlain al{xn, DM};
      EpiGateUp ep{bufB};
      gemm_phase(al, reinterpret_cast<const bf16_t*>(ws + OFF_WGU + f * SZ_WGU), DM, MTOK / 256, 44, ep, sm);
    } break;
    case OP_DOWN: {
      ALoadPlain al{bufB, FF};
      EpiResid ep{(f == 0) ? P->in[0] : xres, xres, 0.5f};
      gemm_phase(al, reinterpret_cast<const bf16_t*>(ws + OFF_WD + f * SZ_WD), FF, MTOK / 256, 8, ep, sm);
    } break;
    case OP_MNORM: phase_rmsnorm(xres, P->in[5] + f * DM, xn); break;
    case OP_WINAB: { ALoadPlain al{xn, DM}; EpiWinAB ep{bufB, reinterpret_cast<bf16_t*>(ws + OFF_C), rope};
              gemm_phase(al, reinterpret_cast<const bf16_t*>(ws + OFF_WINAB), DM, MTOK / 256, 26, ep, sm); } break;
    case OP_MIXAB: phase_mixAB(P, sm); break;
    case OP_RWKVPOST:
      for (int task = bidx(); task < 1024; task += gridDim.x) rwkv_work<1>(P, task >> 4, 0, (task & 15) * 256, (task & 15) * 256 + 256, sm);
      break;
    case OP_WOUT: { ALoadPlain al{xn, DM}; EpiResid ep{xres, xres, 1.f};
              gemm_phase(al, reinterpret_cast<const bf16_t*>(ws + (f ? OFF_WOUTCD : OFF_WOUTAB)), DM, MTOK / 256, 8, ep, sm); } break;
    case OP_WINCD: { ALoadPlain al{xn, DM};
               EpiWinCD ep{bufB, reinterpret_cast<bf16_t*>(ws + OFF_VTS), reinterpret_cast<bf16_t*>(ws + OFF_VTW), rope};
               gemm_phase(al, reinterpret_cast<const bf16_t*>(ws + OFF_WINCD), DM, MTOK / 256, 23, ep, sm); } break;
    case OP_CMP1: {
      const float* bias = reinterpret_cast<const float*>(ws + OFF_BIAS1);
      for (int i = bidx(); i < 64; i += gridDim.x) {
        int kv = i >> 5, r = i & 31, tm = r >> 1, tn = r & 1;
        ALoadCmp al{bufB, kv ? 640 : 512};
        EpiCmp1 ep{reinterpret_cast<bf16_t*>(ws + (kv ? OFF_HIDV : OFF_HIDK)), bias + kv * 256};
        gemm_tile(al, reinterpret_cast<const bf16_t*>(ws + (kv ? OFF_W1V : OFF_W1K)), 2048, tm, tn, ep, sm);
      }
    } break;
    case OP_CMP2: {
      phase_cmp2(P, rope);
    } break;
    case OP_MIXCD: phase_mixCD(P, sm); break;
    case OP_FINAL: phase_finalnorm(xres, P->in[38]); break;
    case OP_MLSTMPOST: phase_mlstm_post(P); break;
  }
}

#if MEGA
#define GSYNC xcd_barrier(xb, kp)
__global__ void __launch_bounds__(NTHR, 2) mega_kernel(Params P) {
  __shared__ __attribute__((aligned(16))) unsigned char sm[65536];
  cg::grid_group grid = cg::this_grid();
  KP kp = (KP)__builtin_amdgcn_kernarg_segment_ptr();
  run_op<OP_PREP>(kp_launder(kp), 0, sm);
  run_op<OP_FNORM>(kp_launder(kp), 0, sm);
  grid.sync();
  XcdBarrier xb;
  xb.x = xb_xcc_id(); xb.nloc = 0u; xb.nx = 0u;
  if (threadIdx.x == 0) (void)xb_add(&reinterpret_cast<unsigned*>(kp->ws + OFF_XBAR)[XB_XCNT(xb.x)], 1u);
  run_op<OP_GATEUP>(kp_launder(kp), 0, sm); GSYNC;
  run_op<OP_DOWN>(kp_launder(kp), 0, sm); GSYNC;
  run_op<OP_MNORM>(kp_launder(kp), 0, sm); GSYNC;
  run_op<OP_WINAB>(kp_launder(kp), 0, sm); GSYNC;
  run_op<OP_MIXAB>(kp_launder(kp), 0, sm); GSYNC;
  run_op<OP_RWKVPOST>(kp_launder(kp), 0, sm); GSYNC;
  run_op<OP_WOUT>(kp_launder(kp), 0, sm); GSYNC;
  run_op<OP_FNORM>(kp_launder(kp), 1, sm); GSYNC;
  run_op<OP_GATEUP>(kp_launder(kp), 1, sm); GSYNC;
  run_op<OP_DOWN>(kp_launder(kp), 1, sm); GSYNC;
  run_op<OP_FNORM>(kp_launder(kp), 2, sm); GSYNC;
  run_op<OP_GATEUP>(kp_launder(kp), 2, sm); GSYNC;
  run_op<OP_DOWN>(kp_launder(kp), 2, sm); GSYNC;
  run_op<OP_MNORM>(kp_launder(kp), 1, sm); GSYNC;
  run_op<OP_WINCD>(kp_launder(kp), 0, sm); GSYNC;
  run_op<OP_CMP1>(kp_launder(kp), 0, sm); GSYNC;
  run_op<OP_CMP2>(kp_launder(kp), 0, sm); GSYNC;
  run_op<OP_MIXCD>(kp_launder(kp), 0, sm); GSYNC;
  run_op<OP_MLSTMPOST>(kp_launder(kp), 0, sm); GSYNC;
  run_op<OP_WOUT>(kp_launder(kp), 1, sm); GSYNC;
  run_op<OP_FNORM>(kp_launder(kp), 3, sm); GSYNC;
  run_op<OP_GATEUP>(kp_launder(kp), 3, sm); GSYNC;
  run_op<OP_DOWN>(kp_launder(kp), 3, sm); GSYNC;
  run_op<OP_FINAL>(kp_launder(kp), 0, sm);
}
#else
template <int OP>
__global__ void __launch_bounds__(NTHR, 2) phase_kernel(Params P, int f) {
  __shared__ __attribute__((aligned(16))) unsigned char sm[65536];
  run_op<OP>((KP)__builtin_amdgcn_kernarg_segment_ptr(), f, sm);
}
#endif

extern "C" void kernel_launch(void* const* d_in, const int* in_sizes, int n_in, void* d_out, int out_size, void* d_ws,
                              size_t ws_size, hipStream_t stream) {
  Params P;
  memset(&P, 0, sizeof(P));
  for (int i = 0; i < 39; ++i) P.in[i] = (const float*)d_in[i];
  P.out = (float*)d_out;
  P.ws = (unsigned char*)d_ws;
#if MEGA
  static int grid_blocks = 0;
  if (!grid_blocks) {
    int dev = 0, cus = 0, per_cu = 0;
    (void)hipGetDevice(&dev);
    (void)hipDeviceGetAttribute(&cus, hipDeviceAttributeMultiprocessorCount, dev);
    (void)hipOccupancyMaxActiveBlocksPerMultiprocessor(&per_cu, mega_kernel, NTHR, 0);
    if (per_cu > 2) per_cu = 2;
    if (per_cu < 1) per_cu = 1;
    grid_blocks = cus * per_cu;
  }
  void* args[] = {&P};
  hipError_t e = hipLaunchCooperativeKernel((void*)mega_kernel, dim3(grid_blocks), dim3(NTHR), args, 0, stream);
  if (e != hipSuccess) fprintf(stderr, "cooperative launch failed: %s (grid %d)\n", hipGetErrorString(e), grid_blocks);
#else
#define LP(OP, F) phase_kernel<OP><<<512, NTHR, 0, stream>>>(P, F)
  LP(OP_PREP, 0);
  for (int layer = 0; layer < 2; ++layer) {
    LP(OP_FNORM, 2 * layer); LP(OP_GATEUP, 2 * layer); LP(OP_DOWN, 2 * layer); LP(OP_MNORM, layer);
    if (layer == 0) { LP(OP_WINAB, 0); LP(OP_MIXAB, 0); LP(OP_RWKVPOST, 0); }
    else { LP(OP_WINCD, 0); LP(OP_CMP1, 0); LP(OP_CMP2, 0); LP(OP_MIXCD, 0); LP(OP_MLSTMPOST, 0); }
    LP(OP_WOUT, layer); LP(OP_FNORM, 2 * layer + 1); LP(OP_GATEUP, 2 * layer + 1); LP(OP_DOWN, 2 * layer + 1);
  }
  LP(OP_FINAL, 0);
#endif
}
```

```cpp
#include <hip/hip_runtime.h>
#include <hip/hip_cooperative_groups.h>
#include <stdint.h>
#include <cstdio>
#include <cstring>
namespace cg = cooperative_groups;

#ifndef MEGA
#define MEGA 1
#endif

typedef unsigned short bf16_t;
using bf16x8 = __attribute__((ext_vector_type(8))) short;
using f32x4 = __attribute__((ext_vector_type(4))) float;
using f32x2 = __attribute__((ext_vector_type(2))) float;

#define NTHR 256
constexpr int T_ = 4096, NB_ = 8, DM = 1024, FF = 2816, MTOK = NB_ * T_;
constexpr int LDAB = 3328, LDCD = 2944;
constexpr size_t MiB = 1048576;
constexpr size_t OFF_WGU = 0;
constexpr size_t SZ_WGU = 11 * MiB;
constexpr size_t OFF_WD = 44 * MiB;
constexpr size_t SZ_WD = 5767168;
constexpr size_t OFF_WINAB = 66 * MiB;
constexpr size_t OFF_WINCD = OFF_WINAB + 6815744;
constexpr size_t OFF_WOUTAB = OFF_WINCD + 6029312;
constexpr size_t OFF_WOUTCD = OFF_WOUTAB + 2 * MiB;
constexpr size_t OFF_W1K = OFF_WOUTCD + 2 * MiB;
constexpr size_t OFF_W1V = OFF_W1K + MiB;
constexpr size_t OFF_W2K = OFF_W1V + MiB;
constexpr size_t OFF_W2V = OFF_W2K + 65536;
constexpr size_t OFF_ROPE = OFF_W2V + 65536;
constexpr size_t OFF_BIAS1 = OFF_ROPE + MiB;
constexpr size_t OFF_MISC = OFF_BIAS1 + 4096;
constexpr size_t OFF_XBAR = OFF_MISC + 4096;
constexpr size_t OFF_A = 88 * MiB;
constexpr size_t OFF_B = 152 * MiB;
constexpr size_t OFF_C = 360 * MiB;
constexpr size_t OFF_Y = 400 * MiB;
constexpr size_t OFF_VTS = OFF_C;
constexpr size_t OFF_VTW = OFF_C + 8 * MiB;
constexpr size_t OFF_HIDK = OFF_C + 16 * MiB;
constexpr size_t OFF_HIDV = OFF_C + 18 * MiB;
constexpr size_t OFF_KCMP = OFF_C + 20 * MiB;
constexpr size_t OFF_VCMPT = OFF_C + 21 * MiB;

struct TJob { const float* src; bf16_t* dst; int K, N, mode, tstart; };
struct Params {
  const float* in[39];
  float* out;
  unsigned char* ws;
};
typedef const __attribute__((address_space(4))) Params* KP;
__device__ __forceinline__ KP kp_launder(KP p) { asm volatile("" : "+s"(p)); return p; }
__device__ __forceinline__ int tidx() { int t = threadIdx.x; asm volatile("" : "+v"(t)); return t; }
__device__ __forceinline__ int bidx() { int t = blockIdx.x; asm volatile("" : "+s"(t)); return t; }
constexpr int TR_FFN = 16 * 44 * 3;
constexpr int TR_TOTAL = 4 * TR_FFN + 16 * 52 + 16 * 45 + 2 * 256 + 2 * 128 + 2 * 4;

__device__ __forceinline__ unsigned short f2bf(float f) {
  unsigned u = __float_as_uint(f); u += 0x7fffu + ((u >> 16) & 1u); return (unsigned short)(u >> 16);
}
__device__ __forceinline__ float bf2f(unsigned short h) { return __uint_as_float(((unsigned)h) << 16); }
__device__ __forceinline__ unsigned pack2(float a, float b) { unsigned r; asm("v_cvt_pk_bf16_f32 %0, %1, %2" : "=v"(r) : "v"(a), "v"(b)); return r; }
__device__ __forceinline__ uint2 pack4(float a, float b, float c, float d) { return make_uint2(pack2(a, b), pack2(c, d)); }
__device__ __forceinline__ float sigmoidf_(float x) { return 1.f / (1.f + __expf(-x)); }
__device__ __forceinline__ float softplusf_(float x) { return fmaxf(x, 0.f) + log1pf(__expf(-fabsf(x))); }
__device__ __forceinline__ float ftanhf_(float x) { float e = __expf(2.f * x); return 1.f - 2.f / (e + 1.f); }
__device__ __forceinline__ int swz(int row, int chunk) { return row * 128 + ((chunk ^ (row & 7)) << 4); }
__device__ __forceinline__ bf16x8 ldsfrag(const unsigned char* tile, int row, int chunk) {
  return *reinterpret_cast<const bf16x8*>(tile + swz(row, chunk));
}
__device__ __forceinline__ bf16x8 ldsfragP(const unsigned char* tile, int row, int s, int g) {
  const unsigned char* r = tile + row * 128 + (g & 1) * 8;
  int c0 = 4 * s + (g >> 1), c1 = c0 + 2, x = row & 7;
  uint2 a = *reinterpret_cast<const uint2*>(r + ((c0 ^ x) << 4));
  uint2 b = *reinterpret_cast<const uint2*>(r + ((c1 ^ x) << 4));
  union { uint4 u; bf16x8 v; } cv; cv.u = make_uint4(a.x, a.y, b.x, b.y); return cv.v;
}
__device__ __forceinline__ bf16x8 packfrag(const f32x4& a, const f32x4& b) {
  union { uint4 u; bf16x8 v; } cv;
  cv.u = make_uint4(pack2(a[0], a[1]), pack2(a[2], a[3]), pack2(b[0], b[1]), pack2(b[2], b[3])); return cv.v;
}
__device__ __forceinline__ bf16x8 u4frag(uint4 u) { union { uint4 u; bf16x8 v; } cv; cv.u = u; return cv.v; }

template <int CTRL>
__device__ __forceinline__ float dppf(float x) {
  return __int_as_float(__builtin_amdgcn_update_dpp(0, __float_as_int(x), CTRL, 0xF, 0xF, true));
}
__device__ __forceinline__ float red4(float x) { x += dppf<0xB1>(x); x += dppf<0x4E>(x); return x; }
__device__ __forceinline__ float red16(float x) { x = red4(x); x += dppf<0x124>(x); x += dppf<0x128>(x); return x; }

template <int CTRL, int RMASK>
__device__ __forceinline__ float dppo(float oldv, float x) {
  return __int_as_float(__builtin_amdgcn_update_dpp(__float_as_int(oldv), __float_as_int(x), CTRL, RMASK, 0xF, false));
}
__device__ __forceinline__ float wave_scan_add(float x) {
  x += dppo<0x111, 0xF>(0.f, x); x += dppo<0x112, 0xF>(0.f, x); x += dppo<0x114, 0xF>(0.f, x); x += dppo<0x118, 0xF>(0.f, x);
  x += dppo<0x142, 0xA>(0.f, x); x += dppo<0x143, 0xC>(0.f, x);
  return x;
}
__device__ __forceinline__ float wave_scan_max(float x) {
  x = fmaxf(x, dppo<0x111, 0xF>(-3e38f, x)); x = fmaxf(x, dppo<0x112, 0xF>(-3e38f, x));
  x = fmaxf(x, dppo<0x114, 0xF>(-3e38f, x)); x = fmaxf(x, dppo<0x118, 0xF>(-3e38f, x));
  x = fmaxf(x, dppo<0x142, 0xA>(-3e38f, x)); x = fmaxf(x, dppo<0x143, 0xC>(-3e38f, x));
  return x;
}
__device__ __forceinline__ float ex2(float x) { return __builtin_amdgcn_exp2f(x); }
#define MFMA(a, b, c) __builtin_amdgcn_mfma_f32_16x16x32_bf16(a, b, c, 0, 0, 0)

__device__ __forceinline__ void transpose_tile(KP P, int tile, unsigned char* smraw) {
  float* sm = reinterpret_cast<float*>(smraw);
  const int tid = tidx();
    TJob J;
    if (tile < 4 * TR_FFN) {
      int f = tile / TR_FFN, r = tile - f * TR_FFN, w = r / 704;
      int layer = f >> 1; bool bsel = f & 1;
      const float* g0 = bsel ? P->in[7] : P->in[2];
      const float* u0 = bsel ? P->in[8] : P->in[3];
      const float* d0 = bsel ? P->in[9] : P->in[4];
      J.src = (w == 0 ? g0 : (w == 1 ? u0 : d0)) + (size_t)layer * DM * FF;
      J.dst = reinterpret_cast<bf16_t*>(P->ws + (w < 2 ? OFF_WGU + f * SZ_WGU : OFF_WD + f * SZ_WD));
      J.K = (w < 2) ? DM : FF; J.N = (w < 2) ? FF : DM; J.mode = (w == 0) ? 1 : (w == 1 ? 2 : 0);
      J.tstart = f * TR_FFN + w * 704;
    } else {
      int r = tile - 4 * TR_FFN;
      if (r < 832) { J.src = P->in[10]; J.dst = reinterpret_cast<bf16_t*>(P->ws + OFF_WINAB); J.K = DM; J.N = 3328; J.tstart = 4 * TR_FFN; }
      else if (r < 1552) { J.src = P->in[25]; J.dst = reinterpret_cast<bf16_t*>(P->ws + OFF_WINCD); J.K = DM; J.N = 2848; J.tstart = 4 * TR_FFN + 832; }
      else if (r < 1808) { J.src = P->in[11]; J.dst = reinterpret_cast<bf16_t*>(P->ws + OFF_WOUTAB); J.K = DM; J.N = DM; J.tstart = 4 * TR_FFN + 1552; }
      else if (r < 2064) { J.src = P->in[26]; J.dst = reinterpret_cast<bf16_t*>(P->ws + OFF_WOUTCD); J.K = DM; J.N = DM; J.tstart = 4 * TR_FFN + 1808; }
      else if (r < 2192) { J.src = P->in[28]; J.dst = reinterpret_cast<bf16_t*>(P->ws + OFF_W1K); J.K = 2048; J.N = 256; J.tstart = 4 * TR_FFN + 2064; }
      else if (r < 2320) { J.src = P->in[31]; J.dst = reinterpret_cast<bf16_t*>(P->ws + OFF_W1V); J.K = 2048; J.N = 256; J.tstart = 4 * TR_FFN + 2192; }
      else if (r < 2324) { J.src = P->in[29]; J.dst = reinterpret_cast<bf16_t*>(P->ws + OFF_W2K); J.K = 256; J.N = 64; J.tstart = 4 * TR_FFN + 2320; }
      else { J.src = P->in[32]; J.dst = reinterpret_cast<bf16_t*>(P->ws + OFF_W2V); J.K = 256; J.N = 64; J.tstart = 4 * TR_FFN + 2324; }
      J.mode = 0;
    }
    int lt = tile - J.tstart;
    int nkt = J.K >> 6;
    int kt = lt % nkt, nt = lt / nkt;
    int k0 = kt * 64, n0 = nt * 64;
    for (int i = tid; i < 4096; i += NTHR) {
      int r = i >> 6, c = i & 63, n = n0 + c;
      sm[r * 65 + c] = (n < J.N) ? J.src[(size_t)(k0 + r) * J.N + n] : 0.f;
    }
    __syncthreads();
    for (int i = tid; i < 4096; i += NTHR) {
      int c = i >> 6, r = i & 63, n = n0 + c;
      if (n < J.N) {
        int drow = (J.mode == 0) ? n : ((n >> 5) * 64 + (n & 31) + (J.mode == 2 ? 32 : 0));
        J.dst[(size_t)drow * J.K + k0 + r] = f2bf(sm[r * 65 + c]);
      }
    }
    __syncthreads();
}

constexpr int TR_EARLY = 2112 + 832;
__device__ __forceinline__ int tr_early_tile(int v) { return v < 2112 ? v : v - 2112 + 4 * TR_FFN; }
__device__ __forceinline__ int tr_late_tile(int v) { return v < 3 * TR_FFN ? v + TR_FFN : v - 3 * TR_FFN + 4 * TR_FFN + 832; }

__device__ __forceinline__ void phase_prep(KP P, unsigned char* smraw) {
  const int tid = tidx();
  for (int v = bidx(); v < TR_EARLY; v += gridDim.x) transpose_tile(P, tr_early_tile(v), smraw);
  const int gtid = bidx() * NTHR + tid, gsz = gridDim.x * NTHR;
  float2* rope = reinterpret_cast<float2*>(P->ws + OFF_ROPE);
  for (int i = gtid; i < T_ * 32; i += gsz) {
    int t = i >> 5, d = i & 31;
    float inv = powf(10000.f, -(float)(2 * d) / 64.f);
    float ang = (float)t * inv;
    rope[i] = make_float2(cosf(ang), sinf(ang));
  }
  {
    bf16_t* w = reinterpret_cast<bf16_t*>(P->ws + OFF_WINCD) + (size_t)2848 * 1024;
    for (int i = gtid; i < 96 * 1024; i += gsz) w[i] = 0;
    bf16_t* a = reinterpret_cast<bf16_t*>(P->ws + OFF_W2K) + 64 * 256;
    bf16_t* b = reinterpret_cast<bf16_t*>(P->ws + OFF_W2V) + 64 * 256;
    for (int i = gtid; i < 64 * 256; i += gsz) { a[i] = 0; b[i] = 0; }
  }
  if (bidx() < 2) {
    const float* pe = (bidx() == 0) ? P->in[27] : P->in[30];
    const float* w1 = (bidx() == 0) ? P->in[28] : P->in[31];
    float acc = 0.f;
    for (int k = 0; k < 2048; ++k) acc += pe[k] * w1[(size_t)k * 256 + tid];
    reinterpret_cast<float*>(P->ws + OFF_BIAS1)[bidx() * 256 + tid] = acc;
  }
  if (bidx() == 2 && tid < 64) {
    const float* lam = P->in[12];
    float a = lam[tid] * lam[64 + tid], b = lam[128 + tid] * lam[192 + tid];
    for (int o = 32; o; o >>= 1) { a += __shfl_xor(a, o); b += __shfl_xor(b, o); }
    if (tid == 0) {
      float* misc = reinterpret_cast<float*>(P->ws + OFF_MISC);
      misc[0] = expf(a) - expf(b) + 0.2f;
    }
  }
  if (bidx() == 4) {
    unsigned* xb = reinterpret_cast<unsigned*>(P->ws + OFF_XBAR);
    for (int i = tid; i < 3456; i += NTHR) xb[i] = 0u;
  }
  if (bidx() == 3 && tid == 0) {
    unsigned* cnt = reinterpret_cast<unsigned*>(P->ws + OFF_MISC + 64);
    cnt[0] = 0; cnt[1] = 0; cnt[2] = 0; cnt[3] = 0;
  }
}

__device__ __forceinline__ void phase_rmsnorm(const float* __restrict__ src, const float* __restrict__ w, bf16_t* __restrict__ dst) {
  const int lane = tidx() & 63, wid = tidx() >> 6;
  for (int row = bidx() * 4 + wid; row < MTOK; row += gridDim.x * 4) {
    const float4* s4 = reinterpret_cast<const float4*>(src + (size_t)row * DM);
    float4 v[4]; float ss = 0.f;
#pragma unroll
    for (int i = 0; i < 4; ++i) { v[i] = s4[lane + 64 * i]; ss += v[i].x * v[i].x + v[i].y * v[i].y + v[i].z * v[i].z + v[i].w * v[i].w; }
    for (int o = 32; o; o >>= 1) ss += __shfl_xor(ss, o);
    float r = rsqrtf(ss * (1.f / DM) + 1e-6f);
#pragma unroll
    for (int i = 0; i < 4; ++i) {
      float4 ww = reinterpret_cast<const float4*>(w)[lane + 64 * i];
      uint2 o = pack4(v[i].x * r * ww.x, v[i].y * r * ww.y, v[i].z * r * ww.z, v[i].w * r * ww.w);
      *reinterpret_cast<uint2*>(dst + (size_t)row * DM + (lane + 64 * i) * 4) = o;
    }
  }
}
__device__ __forceinline__ void phase_finalnorm(float* __restrict__ x, const float* __restrict__ w) {
  const int lane = tidx() & 63, wid = tidx() >> 6;
  for (int row = bidx() * 4 + wid; row < MTOK; row += gridDim.x * 4) {
    float4* s4 = reinterpret_cast<float4*>(x + (size_t)row * DM);
    float4 v[4]; float ss = 0.f;
#pragma unroll
    for (int i = 0; i < 4; ++i) { v[i] = s4[lane + 64 * i]; ss += v[i].x * v[i].x + v[i].y * v[i].y + v[i].z * v[i].z + v[i].w * v[i].w; }
    for (int o = 32; o; o >>= 1) ss += __shfl_xor(ss, o);
    float r = rsqrtf(ss * (1.f / DM) + 1e-6f);
#pragma unroll
    for (int i = 0; i < 4; ++i) {
      float4 ww = reinterpret_cast<const float4*>(w)[lane + 64 * i];
      s4[lane + 64 * i] = make_float4(v[i].x * r * ww.x, v[i].y * r * ww.y, v[i].z * r * ww.z, v[i].w * r * ww.w);
    }
  }
}

struct ALoadPlain {
  const bf16_t* A; int lda;
  __device__ __forceinline__ const bf16_t* ptr(int row, int kt) const { return A + (size_t)row * lda + kt * 64; }
};
struct ALoadCmp {
  const bf16_t* p; int colbase; int kofs;
  __device__ __forceinline__ const bf16_t* ptr(int row, int kt) const {
    int bg = row >> 8, n = row & 255, b = bg >> 1, g = bg & 1;
    int t = min(16 * n + kt + kofs, T_ - 1);
    return p + ((size_t)(b * T_ + t)) * LDCD + colbase + g * 64;
  }
};

__device__ __forceinline__ int swz32(int row, int chunk) { return row * 64 + ((chunk ^ ((-(row >> 2)) & 3)) << 4); }
template <class AF, class EPI>
__device__ __forceinline__ void gemm_tile(const AF& af, const bf16_t* __restrict__ Bt, int K, int tm, int tn,
                                          const EPI& epi, unsigned char* sm, bool pre_issued = false, int ntm = -1, int ntn = -1,
                                          int ldb_ = 0) {
  const int ldb = ldb_ ? ldb_ : K;
  const int tid = tidx(), lane = tid & 63, wid = tid >> 6;
  const int wm = wid >> 1, wn = wid & 1, c16 = lane & 15, g = lane >> 4;
  const int lr = tid >> 2, lc = tid & 3;
  const int nk = K >> 5;
  f32x4 acc[4][8];
#pragma unroll
  for (int i = 0; i < 4; ++i)
#pragma unroll
    for (int j = 0; j < 8; ++j) acc[i][j] = f32x4{0.f, 0.f, 0.f, 0.f};
  const int gc = (lc ^ ((-(lr >> 2)) & 3)) * 8;
  const bf16_t* bp = Bt + (size_t)(tn * 128 + lr) * ldb + gc;
  const int row0 = tm * 256 + lr;
  typedef __attribute__((address_space(3))) unsigned* ldsp_t;
#define GLD(KT, BASE) { const int k_ = (KT); const int ko_ = (k_ & 1) * 32 + gc;                                \
    unsigned char* d_ = (BASE) + tid * 16;                                                                      \
    __builtin_amdgcn_global_load_lds((const unsigned*)(af.ptr(row0, k_ >> 1) + ko_), (ldsp_t)(d_), 16, 0, 0);             \
    __builtin_amdgcn_global_load_lds((const unsigned*)(af.ptr(row0 + 64, k_ >> 1) + ko_), (ldsp_t)(d_ + 4096), 16, 0, 0);  \
    __builtin_amdgcn_global_load_lds((const unsigned*)(af.ptr(row0 + 128, k_ >> 1) + ko_), (ldsp_t)(d_ + 8192), 16, 0, 0); \
    __builtin_amdgcn_global_load_lds((const unsigned*)(af.ptr(row0 + 192, k_ >> 1) + ko_), (ldsp_t)(d_ + 12288), 16, 0, 0);\
    __builtin_amdgcn_global_load_lds((const unsigned*)(bp + k_ * 32), (ldsp_t)(d_ + 16384), 16, 0, 0);                    \
    __builtin_amdgcn_global_load_lds((const unsigned*)(bp + (size_t)64 * ldb + k_ * 32), (ldsp_t)(d_ + 20480), 16, 0, 0); }
#define CMP(BASE) { const unsigned char* sA_ = (BASE); const unsigned char* sB_ = sA_ + 16384;                 \
    bf16x8 wf[4], xf[8];                                                                                        \
    _Pragma("unroll") for (int i = 0; i < 4; ++i) wf[i] = *reinterpret_cast<const bf16x8*>(sB_ + swz32(wn * 64 + i * 16 + c16, g));   \
    _Pragma("unroll") for (int i = 0; i < 8; ++i) xf[i] = *reinterpret_cast<const bf16x8*>(sA_ + swz32(wm * 128 + i * 16 + c16, g));  \
    __builtin_amdgcn_s_setprio(1);                                                                              \
    _Pragma("unroll") for (int mi = 0; mi < 4; ++mi)                                                            \
      _Pragma("unroll") for (int ni = 0; ni < 8; ++ni) acc[mi][ni] = MFMA(wf[mi], xf[ni], acc[mi][ni]);         \
    __builtin_amdgcn_s_setprio(0); }
  if (!pre_issued) { GLD(0, sm) }
  asm volatile("s_waitcnt vmcnt(0)" ::: "memory");
  __syncthreads();
  for (int kt = 0; kt < nk; kt += 2) {
    GLD(kt + 1, sm + 24576)
    CMP(sm)
    asm volatile("s_waitcnt vmcnt(0)" ::: "memory");
    __syncthreads();
    if (kt + 2 < nk) { GLD(kt + 2, sm) }
    CMP(sm + 24576)
    asm volatile("s_waitcnt vmcnt(0)" ::: "memory");
    __syncthreads();
  }
#undef GLD
#undef CMP
  if (ntm >= 0) {
    const bf16_t* nbp = Bt + (size_t)(ntn * 128 + lr) * ldb + gc;
    const int nrow0 = ntm * 256 + lr;
    unsigned char* d_ = sm + tid * 16;
    __builtin_amdgcn_global_load_lds((const unsigned*)(af.ptr(nrow0, 0) + gc), (ldsp_t)(d_), 16, 0, 0);
    __builtin_amdgcn_global_load_lds((const unsigned*)(af.ptr(nrow0 + 64, 0) + gc), (ldsp_t)(d_ + 4096), 16, 0, 0);
    __builtin_amdgcn_global_load_lds((const unsigned*)(af.ptr(nrow0 + 128, 0) + gc), (ldsp_t)(d_ + 8192), 16, 0, 0);
    __builtin_amdgcn_global_load_lds((const unsigned*)(af.ptr(nrow0 + 192, 0) + gc), (ldsp_t)(d_ + 12288), 16, 0, 0);
    __builtin_amdgcn_global_load_lds((const unsigned*)(nbp), (ldsp_t)(d_ + 16384), 16, 0, 0);
    __builtin_amdgcn_global_load_lds((const unsigned*)(nbp + (size_t)64 * ldb), (ldsp_t)(d_ + 20480), 16, 0, 0);
  }
#pragma unroll
  for (int hf = 0; hf < 2; ++hf) {
    __builtin_amdgcn_sched_barrier(0);
    f32x4 sub[4][4];
#pragma unroll
    for (int mi = 0; mi < 4; ++mi)
#pragma unroll
      for (int ni = 0; ni < 4; ++ni) sub[mi][ni] = acc[mi][hf * 4 + ni];
    epi(sub, tm * 256 + wm * 128 + hf * 64, tn * 128 + wn * 64, lane);
  }
}

template <class AF, class EPI>
__device__ __forceinline__ void gemm_phase(const AF& af, const bf16_t* Bt, int K, int ntm, int ntn, const EPI& epi, unsigned char* sm) {
  const int total = ntm * ntn;
  bool pre = false;
  for (int i = bidx(); i < total; i += gridDim.x) {
    int x = i & 7, j = i >> 3;
    int grp = j / (8 * ntn), r = j - grp * 8 * ntn;
    int tn = r >> 3, tml = grp * 8 + (r & 7);
    int tm = tml * 8 + x;
    int i2 = i + gridDim.x, ntm2 = -1, ntn2 = -1;
    if (i2 < total) {
      int x2 = i2 & 7, j2 = i2 >> 3;
      int grp2 = j2 / (8 * ntn), r2 = j2 - grp2 * 8 * ntn;
      ntn2 = r2 >> 3; ntm2 = (grp2 * 8 + (r2 & 7)) * 8 + x2;
    }
    gemm_tile(af, Bt, K, tm, tn, epi, sm, pre, ntm2, ntn2);
    pre = (ntm2 >= 0);
  }
}

struct EpiGateUp {
  bf16_t* hid;
  __device__ __forceinline__ void operator()(f32x4 (&acc)[4][4], int tb, int cb, int lane) const {
    const int c16 = lane & 15, g = lane >> 4;
#pragma unroll
    for (int mi = 0; mi < 2; ++mi)
#pragma unroll
      for (int ni = 0; ni < 4; ++ni) {
        float h[4];
#pragma unroll
        for (int j = 0; j < 4; ++j) { float gg = acc[mi][ni][j], uu = acc[mi + 2][ni][j]; h[j] = gg / (1.f + __expf(-gg)) * uu; }
        int f = (cb >> 6) * 32 + mi * 16 + g * 4;
        int tok = tb + ni * 16 + c16;
        *reinterpret_cast<uint2*>(hid + (size_t)tok * FF + f) = pack4(h[0], h[1], h[2], h[3]);
      }
  }
};
struct EpiResid {
  const float* src; float* dst; float alpha;
  __device__ __forceinline__ void operator()(f32x4 (&acc)[4][4], int tb, int cb, int lane) const {
    const int c16 = lane & 15, g = lane >> 4;
#pragma unroll
    for (int mi = 0; mi < 4; ++mi) {
      __builtin_amdgcn_sched_barrier(0);
#pragma unroll
      for (int ni = 0; ni < 4; ++ni) {
        size_t o = (size_t)(tb + ni * 16 + c16) * DM + cb + mi * 16 + g * 4;
        float4 s = *reinterpret_cast<const float4*>(src + o);
        *reinterpret_cast<float4*>(dst + o) = make_float4(s.x + alpha * acc[mi][ni][0], s.y + alpha * acc[mi][ni][1],
                                                          s.z + alpha * acc[mi][ni][2], s.w + alpha * acc[mi][ni][3]);
      }
    }
  }
};
__device__ __forceinline__ void rope_wave(f32x4 (&acc)[4][4], int tb, int lane, const float2* rope, float scale) {
  const int c16 = lane & 15, g = lane >> 4;
#pragma unroll
  for (int ni = 0; ni < 4; ++ni) {
    int t = (tb + ni * 16 + c16) & (T_ - 1);
#pragma unroll
    for (int mi = 0; mi < 2; ++mi)
#pragma unroll
      for (int j = 0; j < 4; ++j) {
        float2 cs = rope[t * 32 + mi * 16 + g * 4 + j];
        float x1 = acc[mi][ni][j], x2 = acc[mi + 2][ni][j];
        acc[mi][ni][j] = (x1 * cs.x - x2 * cs.y) * scale;
        acc[mi + 2][ni][j] = (x2 * cs.x + x1 * cs.y) * scale;
      }
  }
}
__device__ __forceinline__ void store_p(f32x4 (&acc)[4][4], int tb, int cb, int lane, bf16_t* p, int ld) {
  const int c16 = lane & 15, g = lane >> 4;
#pragma unroll
  for (int mi = 0; mi < 4; ++mi)
#pragma unroll
    for (int ni = 0; ni < 4; ++ni)
      *reinterpret_cast<uint2*>(p + (size_t)(tb + ni * 16 + c16) * ld + cb + mi * 16 + g * 4) =
          pack4(acc[mi][ni][0], acc[mi][ni][1], acc[mi][ni][2], acc[mi][ni][3]);
}
__device__ __forceinline__ void store_vt(f32x4 (&acc)[4][4], int tb, int lane, bf16_t* vt, int ebase) {
  const int c16 = lane & 15, g = lane >> 4;
#pragma unroll
  for (int ni = 0; ni < 4; ++ni) {
    int t = (tb + ni * 16 + c16) & (T_ - 1);
#pragma unroll
    for (int mi = 0; mi < 4; ++mi)
#pragma unroll
      for (int j = 0; j < 4; ++j) vt[(size_t)(ebase + mi * 16 + g * 4 + j) * T_ + t] = f2bf(acc[mi][ni][j]);
  }
}
struct EpiWinAB {
  bf16_t* p; bf16_t* vta; const float2* rope;
  __device__ __forceinline__ void operator()(f32x4 (&acc)[4][4], int tb, int cb, int lane) const {
    if (cb < 1024) rope_wave(acc, tb, lane, rope, cb < 512 ? 0.125f * 1.4426950408889634f : 1.f);
    store_p(acc, tb, cb, lane, p, LDAB);
    if (cb >= 1024 && cb < 1536) {
      int b = tb >> 12;
      store_vt(acc, tb, lane, vta + (size_t)b * 512 * T_, cb - 1024);
    }
  }
};
struct EpiWinCD {
  bf16_t* p; bf16_t* vts; bf16_t* vtw; const float2* rope;
  __device__ __forceinline__ void operator()(f32x4 (&acc)[4][4], int tb, int cb, int lane) const {
    if (cb < 512) rope_wave(acc, tb, lane, rope, 0.125f * 1.4426950408889634f);
    else if ((cb >= 768 && cb < 896) || (cb >= 1024 && cb < 1152)) rope_wave(acc, tb, lane, rope, 1.f);
    store_p(acc, tb, cb, lane, p, LDCD);
    int b = tb >> 12;
    if (cb >= 896 && cb < 1024) store_vt(acc, tb, lane, vts + (size_t)b * 128 * T_, cb - 896);
    if (cb >= 1152 && cb < 1280) store_vt(acc, tb, lane, vtw + (size_t)b * 128 * T_, cb - 1152);
  }
};
struct EpiCmp1 {
  bf16_t* hid; const float* bias;
  __device__ __forceinline__ void operator()(f32x4 (&acc)[4][4], int tb, int cb, int lane) const {
    const int c16 = lane & 15, g = lane >> 4;
#pragma unroll
    for (int mi = 0; mi < 4; ++mi) {
      int c = cb + mi * 16 + g * 4;
      float4 bb = *reinterpret_cast<const float4*>(bias + c);
      float bv[4] = {bb.x, bb.y, bb.z, bb.w};
#pragma unroll
      for (int ni = 0; ni < 4; ++ni) {
        float h[4];
#pragma unroll
        for (int j = 0; j < 4; ++j) {
          float x = acc[mi][ni][j] + bv[j];
          float u = 0.7978845608028654f * (x + 0.044715f * x * x * x);
          h[j] = 0.5f * x * (1.f + tanhf(u));
        }
        *reinterpret_cast<uint2*>(hid + (size_t)(tb + ni * 16 + c16) * 256 + c) = pack4(h[0], h[1], h[2], h[3]);
      }
    }
  }
};
struct EpiCmp1P {
  float* part;
  __device__ __forceinline__ void operator()(f32x4 (&acc)[4][4], int tb, int cb, int lane) const {
    const int c16 = lane & 15, g = lane >> 4;
#pragma unroll
    for (int mi = 0; mi < 4; ++mi)
#pragma unroll
      for (int ni = 0; ni < 4; ++ni)
        *reinterpret_cast<float4*>(part + (size_t)(tb + ni * 16 + c16) * 256 + cb + mi * 16 + g * 4) =
            make_float4(acc[mi][ni][0], acc[mi][ni][1], acc[mi][ni][2], acc[mi][ni][3]);
  }
};
__device__ __forceinline__ void phase_cmp2(KP P, const float2* rope) {
  const int tid = tidx(), lane = tid & 63, wid = tid >> 6, c16 = lane & 15, g = lane >> 4;
  for (int task = bidx() * 4 + wid; task < 512; task += gridDim.x * 4) {
    const int kv = task >> 8, R0 = (task & 255) * 16;
    const float* part = reinterpret_cast<const float*>(P->ws + OFF_Y) + (size_t)kv * 4 * 4096 * 256;
    const float* bias = reinterpret_cast<const float*>(P->ws + OFF_BIAS1) + kv * 256;
    const bf16_t* w2 = reinterpret_cast<const bf16_t*>(P->ws + (kv ? OFF_W2V : OFF_W2K));
    f32x4 acc[4];
#pragma unroll
    for (int mi = 0; mi < 4; ++mi) acc[mi] = f32x4{0.f, 0.f, 0.f, 0.f};
#pragma unroll
    for (int ks = 0; ks < 8; ++ks) {
      bf16x8 xf;
      {
        const int c0 = ks * 32 + g * 8;
        float x[8];
        float4 b0 = *reinterpret_cast<const float4*>(bias + c0), b1 = *reinterpret_cast<const float4*>(bias + c0 + 4);
        x[0] = b0.x; x[1] = b0.y; x[2] = b0.z; x[3] = b0.w; x[4] = b1.x; x[5] = b1.y; x[6] = b1.z; x[7] = b1.w;
#pragma unroll
        for (int sp = 0; sp < 4; ++sp) {
          const float* pr = part + ((size_t)sp * 4096 + R0 + c16) * 256 + c0;
          float4 p0 = *reinterpret_cast<const float4*>(pr), p1 = *reinterpret_cast<const float4*>(pr + 4);
          x[0] += p0.x; x[1] += p0.y; x[2] += p0.z; x[3] += p0.w; x[4] += p1.x; x[5] += p1.y; x[6] += p1.z; x[7] += p1.w;
        }
#pragma unroll
        for (int e = 0; e < 8; ++e) {
          float u = 0.7978845608028654f * (x[e] + 0.044715f * x[e] * x[e] * x[e]);
          x[e] = 0.5f * x[e] * (1.f + tanhf(u));
        }
        xf = u4frag(make_uint4(pack2(x[0], x[1]), pack2(x[2], x[3]), pack2(x[4], x[5]), pack2(x[6], x[7])));
      }
#pragma unroll
      for (int mi = 0; mi < 4; ++mi) {
        bf16x8 wf = u4frag(*reinterpret_cast<const uint4*>(w2 + (size_t)(mi * 16 + c16) * 256 + ks * 32 + g * 8));
        acc[mi] = MFMA(wf, xf, acc[mi]);
      }
    }
    const int R = R0 + c16, bg = R >> 8, n = R & 255;
    if (kv == 0) {
      bf16_t* dst = reinterpret_cast<bf16_t*>(P->ws + OFF_KCMP);
      int pos = min(16 * n + 31, T_ - 1);
#pragma unroll
      for (int mi = 0; mi < 2; ++mi)
#pragma unroll
        for (int j = 0; j < 4; ++j) {
          float2 cs = rope[pos * 32 + mi * 16 + g * 4 + j];
          float x1 = acc[mi][j], x2 = acc[mi + 2][j];
          acc[mi][j] = x1 * cs.x - x2 * cs.y;
          acc[mi + 2][j] = x2 * cs.x + x1 * cs.y;
        }
#pragma unroll
      for (int mi = 0; mi < 4; ++mi)
        *reinterpret_cast<uint2*>(dst + ((size_t)bg * 256 + n) * 64 + mi * 16 + g * 4) = pack4(acc[mi][0], acc[mi][1], acc[mi][2], acc[mi][3]);
    } else {
      bf16_t* dst = reinterpret_cast<bf16_t*>(P->ws + OFF_VCMPT);
#pragma unroll
      for (int mi = 0; mi < 4; ++mi)
#pragma unroll
        for (int j = 0; j < 4; ++j) dst[((size_t)bg * 64 + mi * 16 + g * 4 + j) * 256 + n] = f2bf(acc[mi][j]);
    }
  }
}

template <int EM, class MaskF>
__device__ __forceinline__ void flash_tile(f32x4 (&O)[EM][2], float (&m)[2], float (&l)[2], const bf16x8 (&qf)[2][2],
                                           const unsigned char* Ks, const unsigned char* Vs, bool domask, bool first, int lane,
                                           const MaskF& valid) {
  const int c16 = lane & 15, g = lane >> 4;
  f32x4 S[4][2];
#pragma unroll
  for (int mi = 0; mi < 4; ++mi) {
    S[mi][0] = f32x4{-m[0], -m[0], -m[0], -m[0]}; S[mi][1] = f32x4{-m[1], -m[1], -m[1], -m[1]};
#pragma unroll
    for (int ks = 0; ks < 2; ++ks) {
      bf16x8 kf = ldsfrag(Ks, mi * 16 + c16, ks * 4 + g);
      S[mi][0] = MFMA(kf, qf[0][ks], S[mi][0]);
      S[mi][1] = MFMA(kf, qf[1][ks], S[mi][1]);
    }
  }
  if (domask) {
#pragma unroll
    for (int mi = 0; mi < 4; ++mi)
#pragma unroll
      for (int ni = 0; ni < 2; ++ni)
#pragma unroll
        for (int j = 0; j < 4; ++j)
          if (!valid(mi * 16 + g * 4 + j, ni)) S[mi][ni][j] = -1e30f;
  }
  float mx[2];
#pragma unroll
  for (int ni = 0; ni < 2; ++ni) {
    float v = -1e30f;
#pragma unroll
    for (int mi = 0; mi < 4; ++mi)
#pragma unroll
      for (int j = 0; j < 4; ++j) v = fmaxf(v, S[mi][ni][j]);
    mx[ni] = v;
  }
  if (__any(first || mx[0] > 8.f || mx[1] > 8.f)) {
#pragma unroll
    for (int ni = 0; ni < 2; ++ni) {
      float v = mx[ni];
      v = fmaxf(v, __shfl_xor(v, 16));
      v = fmaxf(v, __shfl_xor(v, 32));
      float delta = (v > -1e29f) ? (first ? v : fmaxf(v, 0.f)) : 0.f;
      float al = ex2(-delta);
      m[ni] += delta;
      l[ni] *= al;
#pragma unroll
      for (int me = 0; me < EM; ++me) { O[me][ni][0] *= al; O[me][ni][1] *= al; O[me][ni][2] *= al; O[me][ni][3] *= al; }
#pragma unroll
      for (int mi = 0; mi < 4; ++mi) { S[mi][ni][0] -= delta; S[mi][ni][1] -= delta; S[mi][ni][2] -= delta; S[mi][ni][3] -= delta; }
    }
  }
#pragma unroll
  for (int ni = 0; ni < 2; ++ni) {
    float rs = 0.f;
#pragma unroll
    for (int mi = 0; mi < 4; ++mi)
#pragma unroll
      for (int j = 0; j < 4; ++j) {
        float pv = ex2(S[mi][ni][j]);
        S[mi][ni][j] = pv; rs += pv;
      }
    l[ni] += rs;
  }
  bf16x8 pf[2][2];
#pragma unroll
  for (int ni = 0; ni < 2; ++ni) { pf[ni][0] = packfrag(S[0][ni], S[1][ni]); pf[ni][1] = packfrag(S[2][ni], S[3][ni]); }
#pragma unroll
  for (int me = 0; me < EM; ++me)
#pragma unroll
    for (int s = 0; s < 2; ++s) {
      bf16x8 vf = ldsfragP(Vs, me * 16 + c16, s, g);
      O[me][0] = MFMA(vf, pf[0][s], O[me][0]);
      O[me][1] = MFMA(vf, pf[1][s], O[me][1]);
    }
}

__device__ __forceinline__ void load_tile(unsigned char* dst, const bf16_t* src, size_t ld, int rows) {
  for (int i = tidx(); i < rows * 8; i += NTHR) {
    int r = i >> 3, c = i & 7;
    *reinterpret_cast<uint4*>(dst + swz(r, c)) = *reinterpret_cast<const uint4*>(src + (size_t)r * ld + c * 8);
  }
}


__device__ __forceinline__ void load_tile_dma(unsigned char* dst, const bf16_t* src, size_t ld, int rows) {
  typedef __attribute__((address_space(3))) unsigned* ldsp_t;
  const int tid = tidx();
  for (int i = tid; i < rows * 8; i += NTHR) {
    int r = i >> 3, c = (i & 7) ^ (r & 7);
    __builtin_amdgcn_global_load_lds((const unsigned*)(src + (size_t)r * ld + c * 8), (ldsp_t)(dst + i * 16), 16, 0, 0);
  }
}

__device__ __forceinline__ void diffattn_item(KP P, int item, unsigned char* sm) {
  const int tid = tidx(), lane = tid & 63, wid = tid >> 6, c16 = lane & 15, g = lane >> 4;
  const int qb = 63 - (item >> 5);
  const int bh = item & 31, b = bh >> 2, h = bh & 3;
  const int comp = wid >> 1, qh = wid & 1;
  const bf16_t* p = reinterpret_cast<const bf16_t*>(P->ws + OFF_B) + (size_t)b * T_ * LDAB;
  const bf16_t* vt = reinterpret_cast<const bf16_t*>(P->ws + OFF_C) + (size_t)(b * 4 + h) * 128 * T_;
  bf16_t* mix = reinterpret_cast<bf16_t*>(P->ws + OFF_A);
  const int t0 = qb * 64, tq0 = t0 + qh * 32;
  bf16x8 qf[2][2];
#pragma unroll
  for (int ni = 0; ni < 2; ++ni)
#pragma unroll
    for (int ks = 0; ks < 2; ++ks)
      qf[ni][ks] = u4frag(*reinterpret_cast<const uint4*>(p + (size_t)(tq0 + ni * 16 + c16) * LDAB + h * 128 + comp * 64 + (ks * 4 + g) * 8));
  f32x4 O[8][2];
#pragma unroll
  for (int i = 0; i < 8; ++i) { O[i][0] = f32x4{0.f, 0.f, 0.f, 0.f}; O[i][1] = f32x4{0.f, 0.f, 0.f, 0.f}; }
  float m[2] = {0.f, 0.f}, l[2] = {0.f, 0.f};
  __syncthreads();
  load_tile_dma(sm, p + 512 + h * 128, LDAB, 64);
  load_tile_dma(sm + 8192, p + 512 + h * 128 + 64, LDAB, 64);
  load_tile_dma(sm + 16384, vt, T_, 128);
  asm volatile("s_waitcnt vmcnt(0)" ::: "memory");
  __syncthreads();
  for (int kt = 0; kt <= qb; ++kt) {
    unsigned char* cur = sm + (kt & 1) * 32768;
    if (kt < qb) {
      unsigned char* nxt = sm + ((kt + 1) & 1) * 32768;
      load_tile_dma(nxt, p + (size_t)((kt + 1) * 64) * LDAB + 512 + h * 128, LDAB, 64);
      load_tile_dma(nxt + 8192, p + (size_t)((kt + 1) * 64) * LDAB + 512 + h * 128 + 64, LDAB, 64);
      load_tile_dma(nxt + 16384, vt + (kt + 1) * 64, T_, 128);
    }
    const int kbase = kt * 64;
    flash_tile<8>(O, m, l, qf, cur + (comp ? 8192 : 0), cur + 16384, kt == qb, kt == 0, lane,
                  [&](int key, int ni) { return kbase + key <= tq0 + ni * 16 + c16; });
    asm volatile("s_waitcnt vmcnt(0)" ::: "memory");
    __syncthreads();
  }
#pragma unroll
  for (int ni = 0; ni < 2; ++ni) { l[ni] += __shfl_xor(l[ni], 16); l[ni] += __shfl_xor(l[ni], 32); }
  __syncthreads();
  float* X = reinterpret_cast<float*>(sm);
  const float lam = reinterpret_cast<const float*>(P->ws + OFF_MISC)[0];
  if (comp == 1) {
#pragma unroll
    for (int ni = 0; ni < 2; ++ni) {
      float sc = lam / l[ni];
#pragma unroll
      for (int me = 0; me < 8; ++me)
#pragma unroll
        for (int j = 0; j < 4; ++j) X[(me * 16 + g * 4 + j) * 64 + qh * 32 + ni * 16 + c16] = O[me][ni][j] * sc;
    }
  }
  __syncthreads();
  if (comp == 0) {
    const float* subln = P->in[13];
#pragma unroll
    for (int ni = 0; ni < 2; ++ni) {
      float il = 1.f / l[ni], ss = 0.f;
#pragma unroll
      for (int me = 0; me < 8; ++me)
#pragma unroll
        for (int j = 0; j < 4; ++j) {
          float v = O[me][ni][j] * il - X[(me * 16 + g * 4 + j) * 64 + qh * 32 + ni * 16 + c16];
          O[me][ni][j] = v; ss += v * v;
        }
      ss += __shfl_xor(ss, 16); ss += __shfl_xor(ss, 32);
      float r = rsqrtf(ss * (1.f / 128.f) + 1e-6f) * 0.8f;
      size_t row = (size_t)(b * T_ + tq0 + ni * 16 + c16) * DM + h * 128;
#pragma unroll
      for (int me = 0; me < 8; ++me) {
        int e = me * 16 + g * 4;
        float4 w = *reinterpret_cast<const float4*>(subln + e);
        *reinterpret_cast<uint2*>(mix + row + e) =
            pack4(O[me][ni][0] * r * w.x, O[me][ni][1] * r * w.y, O[me][ni][2] * r * w.z, O[me][ni][3] * r * w.w);
      }
    }
  }
  __syncthreads();
}

__device__ __forceinline__ float red8(float x) { x = red4(x); x += dppf<0x141>(x); return x; }

template <int MODE>
__device__ __forceinline__ void rwkv_work(KP P, int chain, int half, int tbeg, int tend, unsigned char* sm) {
  constexpr int CH = 32;
  constexpr int NIT = (MODE == 0) ? 5 : 7;
  const int tid = tidx(), lane = tid & 63, wid = tid >> 6, c16 = lane & 15, g = lane >> 4;
  const int b = chain >> 3, h = chain & 7;
  const bf16_t* p = reinterpret_cast<const bf16_t*>(P->ws + OFF_B) + (size_t)b * T_ * LDAB;
  bf16_t* mix = reinterpret_cast<bf16_t*>(P->ws + OFF_A);
  float* ybuf = reinterpret_cast<float*>(P->ws + OFF_Y);
  float* xr = reinterpret_cast<float*>(sm);
  float* xk = xr + CH * 64;
  float* xv = xk + CH * 64;
  float* dec = xv + CH * 64;
  float* av = (MODE == 0) ? dec + CH * 64 : xv + CH * 64;
  float* kkv = av + CH * 64;
  float* gv = av + CH * 64;
  unsigned char* twl = sm + 49152;
  unsigned char* xal = (MODE == 0) ? sm + 53248 : sm + 40960;
  unsigned char* sgl = sm + 45056;
  float* mus = reinterpret_cast<float*>(sm + 57344);
  float* bonus = mus + 448;
  float* cst = bonus + CH;
  float* sc2 = cst + 448;
  for (int i = tid; i < 448; i += NTHR) {
    int a = i >> 6, n = h * 64 + (i & 63);
    const float* src = (a == 0) ? P->in[15] : (a == 1) ? P->in[17] : (a == 2) ? P->in[20] : (a == 3) ? P->in[21] : (a == 4) ? P->in[22] : (a == 5) ? P->in[23] : P->in[24];
    cst[i] = src[n];
  }
  for (int i = tid; i < 448; i += NTHR) {
    int ch = i >> 3, e = i & 7;
    int col = (ch < 24) ? ((ch >> 3) * 512 + h * 64 + (ch & 7) * 8) : (1536 + (ch - 24) * 8);
    mus[i] = P->in[14][col + e];
  }
  bf16x8 w2f[2], a2f[2], g2f[4];
  {
    const float* w2 = P->in[16]; const float* a2 = P->in[18]; const float* g2 = P->in[19];
    int n = h * 64 + wid * 16 + c16;
#pragma unroll
    for (int ks = 0; ks < 2; ++ks)
#pragma unroll
      for (int jj = 0; jj < 8; ++jj) {
        int k = ks * 32 + g * 8 + jj;
        if (MODE == 0) w2f[ks][jj] = (short)f2bf(w2[k * 512 + n]);
        a2f[ks][jj] = (short)f2bf(a2[k * 512 + n]);
      }
    if (MODE == 1) {
#pragma unroll
      for (int ks = 0; ks < 4; ++ks)
#pragma unroll
        for (int jj = 0; jj < 8; ++jj) g2f[ks][jj] = (short)f2bf(g2[(ks * 32 + g * 8 + jj) * 512 + n]);
    }
  }
  const int tokc = tid >> 4, colc = (tid & 15) * 4;
  const int vrow = half * 16 + (tid >> 4), kq = tid & 15;
  f32x2 S2[2];
#pragma unroll
  for (int i = 0; i < 2; ++i) S2[i] = f32x2{0.f, 0.f};
  __syncthreads();
  const int wuu = __builtin_amdgcn_readfirstlane(wid);
  uint4 rcu[NIT], rpu[NIT];
  auto item_of = [&](int it, int& tok, int& ch) -> int {
    int sl = it * 4 + wuu;
    if (MODE == 1 && sl >= 12) sl += 4;
    if (sl < 12) { int j = sl * 64 + lane; tok = j / 24; ch = j - tok * 24; return 0; }
    if (sl < 16) { int j = (sl - 12) * 64 + lane; tok = j >> 3; ch = 24 + (j & 7); return 1; }
    if (sl < 20) { int j = (sl - 16) * 64 + lane; tok = j >> 3; ch = 32 + (j & 7); return 2; }
    if (MODE == 1 && sl < 28) { int j = (sl - 20) * 64 + lane; tok = j >> 4; ch = 40 + (j & 15); return 3; }
    tok = 0; ch = 0; return -1;
  };
  auto issue_a = [&](int t0n) {
#pragma unroll
    for (int it = 0; it < NIT; ++it) {
      int tok, ch;
      int ty = item_of(it, tok, ch);
      rcu[it] = make_uint4(0, 0, 0, 0); rpu[it] = make_uint4(0, 0, 0, 0);
      if (ty >= 0) {
        int col = 1536 + ((ch < 24) ? ((ch >> 3) * 512 + h * 64 + (ch & 7) * 8) : (1536 + (ch - 24) * 8));
        int t = t0n + tok;
        rcu[it] = *reinterpret_cast<const uint4*>(p + (size_t)t * LDAB + col);
        if (t > 0) rpu[it] = *reinterpret_cast<const uint4*>(p + (size_t)(t - 1) * LDAB + col);
      }
    }
  };
  issue_a(tbeg);
  for (int t0 = tbeg; t0 < tend; t0 += CH) {
#pragma unroll
    for (int it = 0; it < NIT; ++it) {
      int tok, ch;
      int ty = item_of(it, tok, ch);
      if (ty >= 0) {
        uint4 cu = rcu[it], pu = rpu[it];
        const unsigned cw[4] = {cu.x, cu.y, cu.z, cu.w}, pw[4] = {pu.x, pu.y, pu.z, pu.w};
        float xm[8];
#pragma unroll
        for (int e = 0; e < 8; ++e) {
          float c = bf2f((unsigned short)(cw[e >> 1] >> ((e & 1) * 16)));
          float q = bf2f((unsigned short)(pw[e >> 1] >> ((e & 1) * 16)));
          xm[e] = c + (q - c) * mus[ch * 8 + e];
        }
        if (ty == 0) {
          float* d = xr + (ch >> 3) * (CH * 64) + tok * 64 + (ch & 7) * 8;
          *reinterpret_cast<float4*>(d) = make_float4(xm[0], xm[1], xm[2], xm[3]);
          *reinterpret_cast<float4*>(d + 4) = make_float4(xm[4], xm[5], xm[6], xm[7]);
        } else {
          unsigned char* d;
          if (ty == 1) { d = twl + swz(tok, ch - 24);
#pragma unroll
            for (int e = 0; e < 8; ++e) xm[e] = ftanhf_(xm[e]); }
          else if (ty == 2) d = xal + swz(tok, ch - 32);
          else { d = sgl + ((ch - 40) >> 3) * 4096 + swz(tok, (ch - 40) & 7);
#pragma unroll
            for (int e = 0; e < 8; ++e) xm[e] = sigmoidf_(xm[e]); }
          *reinterpret_cast<uint4*>(d) = make_uint4(pack2(xm[0], xm[1]), pack2(xm[2], xm[3]), pack2(xm[4], xm[5]), pack2(xm[6], xm[7]));
        }
      }
    }
    if (t0 + CH < tend) issue_a(t0 + CH);
    __syncthreads();
#pragma unroll
    for (int nt = 0; nt < 2; ++nt) {
      f32x4 aw = {0.f, 0.f, 0.f, 0.f}, aa = {0.f, 0.f, 0.f, 0.f}, ag = {0.f, 0.f, 0.f, 0.f};
#pragma unroll
      for (int ks = 0; ks < 2; ++ks) {
        if (MODE == 0) aw = MFMA(w2f[ks], ldsfrag(twl, nt * 16 + c16, ks * 4 + g), aw);
        aa = MFMA(a2f[ks], ldsfrag(xal, nt * 16 + c16, ks * 4 + g), aa);
      }
      if (MODE == 1) {
#pragma unroll
        for (int ks = 0; ks < 4; ++ks) ag = MFMA(g2f[ks], ldsfrag(sgl + (ks >> 1) * 4096, nt * 16 + c16, (ks & 1) * 4 + g), ag);
      }
      float dv[4], a4[4];
      const float4 w04 = *reinterpret_cast<const float4*>(cst + wid * 16 + g * 4);
      const float4 a04 = *reinterpret_cast<const float4*>(cst + 64 + wid * 16 + g * 4);
      const float w0c[4] = {w04.x, w04.y, w04.z, w04.w}, a0c[4] = {a04.x, a04.y, a04.z, a04.w};
#pragma unroll
      for (int j = 0; j < 4; ++j) {
        if (MODE == 0) {
          float wv = w0c[j] + aw[j];
          float w = -__logf(1.f + __expf(-wv)) - 0.5f;
          dv[j] = __expf(-__expf(w));
        }
        a4[j] = sigmoidf_(a0c[j] + aa[j]);
      }
      int o = (nt * 16 + c16) * 64 + wid * 16 + g * 4;
      if (MODE == 0) *reinterpret_cast<float4*>(dec + o) = make_float4(dv[0], dv[1], dv[2], dv[3]);
      *reinterpret_cast<float4*>(av + o) = make_float4(a4[0], a4[1], a4[2], a4[3]);
      if (MODE == 1) *reinterpret_cast<float4*>(gv + o) = make_float4(ag[0], ag[1], ag[2], ag[3]);
    }
    __syncthreads();
#pragma unroll
    for (int tt = 0; tt < 2; ++tt) {
      const int tk = tokc + tt * 16;
      int o = tk * 64 + colc;
      float4 k4 = *reinterpret_cast<float4*>(xk + o), a4 = *reinterpret_cast<float4*>(av + o), r4 = *reinterpret_cast<float4*>(xr + o);
      float k[4] = {k4.x, k4.y, k4.z, k4.w}, a[4] = {a4.x, a4.y, a4.z, a4.w}, r[4] = {r4.x, r4.y, r4.z, r4.w};
      const float4 c0 = *reinterpret_cast<const float4*>(cst + 128 + colc);
      const float4 c1 = *reinterpret_cast<const float4*>(cst + 192 + colc);
      const float4 c2 = *reinterpret_cast<const float4*>(cst + 256 + colc);
      const float kkc[4] = {c0.x, c0.y, c0.z, c0.w}, kac[4] = {c1.x, c1.y, c1.z, c1.w}, rkc[4] = {c2.x, c2.y, c2.z, c2.w};
      float kk[4], kp[4], ss = 0.f, bs = 0.f;
#pragma unroll
      for (int i = 0; i < 4; ++i) {
        kk[i] = k[i] * kkc[i]; ss += kk[i] * kk[i];
        kp[i] = k[i] * (1.f + (a[i] - 1.f) * kac[i]);
        bs += r[i] * kp[i] * rkc[i];
      }
      if (MODE == 1) {
        bs = red16(bs);
        if ((tid & 15) == 0) bonus[tk] = bs;
      } else {
        ss = red16(ss);
        float rn = rsqrtf(ss + 1e-12f);
        float4 d4 = *reinterpret_cast<float4*>(dec + o);
        const float dd[4] = {d4.x, d4.y, d4.z, d4.w};
        float brs = 0.f, krs = 0.f, bv4[4];
#pragma unroll
        for (int i = 0; i < 4; ++i) { kk[i] *= rn; bv4[i] = kk[i] * a[i]; brs += bv4[i] * r[i]; krs += kp[i] * r[i]; }
        brs = red16(brs); krs = red16(krs);
        *reinterpret_cast<float4*>(kkv + o) = make_float4(kk[0], kk[1], kk[2], kk[3]);
        *reinterpret_cast<float4*>(av + o) = make_float4(bv4[0], bv4[1], bv4[2], bv4[3]);
        *reinterpret_cast<float4*>(xk + o) = make_float4(kp[0], kp[1], kp[2], kp[3]);
        *reinterpret_cast<float4*>(xr + o) = make_float4(dd[0] * r[0], dd[1] * r[1], dd[2] * r[2], dd[3] * r[3]);
        if ((tid & 15) == 0) { sc2[tk * 2] = brs; sc2[tk * 2 + 1] = krs; }
      }
    }
    __syncthreads();
    if (MODE == 0) {
      const int ko = kq * 4;
      f32x2 K2[2], W2[2], D2[2], P2[2], B2[2];
#define LD4(DST, SRC) { float4 t4 = *reinterpret_cast<const float4*>(SRC); DST[0] = f32x2{t4.x, t4.y}; DST[1] = f32x2{t4.z, t4.w}; }
      LD4(K2, kkv + ko) LD4(W2, xr + ko) LD4(D2, dec + ko) LD4(P2, xk + ko) LD4(B2, av + ko)
      float vv = xv[vrow];
      const float2 scl = *reinterpret_cast<const float2*>(sc2 + (lane & (CH - 1)) * 2);
      float* yout = ybuf + (size_t)(b * T_ + t0) * 512 + h * 64 + vrow;
#pragma unroll 2
      for (int t = 0; t < CH; ++t) {
        const int tn1 = (t < CH - 1 ? t + 1 : CH - 1);
        const int tn = tn1 * 64 + ko;
        float vvn = xv[tn1 * 64 + vrow];
        f32x2 sa2 = S2[0] * K2[0] + S2[1] * K2[1];
        f32x2 ya2 = S2[0] * W2[0] + S2[1] * W2[1];
        LD4(K2, kkv + tn) LD4(W2, xr + tn)
        const f32x2 vv2 = f32x2{vv, vv};
        f32x2 tmp0 = S2[0] * D2[0] + vv2 * P2[0], tmp1 = S2[1] * D2[1] + vv2 * P2[1];
        float sa = red16(sa2[0] + sa2[1]);
        float ya = red16(ya2[0] + ya2[1]);
        const f32x2 nsa2 = f32x2{-sa, -sa};
        S2[0] = tmp0 + nsa2 * B2[0]; S2[1] = tmp1 + nsa2 * B2[1];
        const float brs = __int_as_float(__builtin_amdgcn_readlane(__float_as_int(scl.x), t));
        const float krs = __int_as_float(__builtin_amdgcn_readlane(__float_as_int(scl.y), t));
        float y = ya - sa * brs + vv * krs;
        asm volatile("" : "+v"(y));
        if (kq == 0) yout[(size_t)t * 512] = y;
        LD4(D2, dec + tn) LD4(P2, xk + tn) LD4(B2, av + tn)
        asm volatile("" : "+v"(vvn));
        vv = vvn;
      }
#undef LD4
    } else {
#pragma unroll
      for (int tt = 0; tt < 2; ++tt) {
        const int tk = tokc + tt * 16;
        int o = tk * 64 + colc;
        float4 y4 = *reinterpret_cast<const float4*>(ybuf + (size_t)(b * T_ + t0 + tk) * 512 + h * 64 + colc);
        float4 v4 = *reinterpret_cast<float4*>(xv + o), g4 = *reinterpret_cast<float4*>(gv + o);
        float y[4] = {y4.x, y4.y, y4.z, y4.w}, v[4] = {v4.x, v4.y, v4.z, v4.w}, gg[4] = {g4.x, g4.y, g4.z, g4.w};
        const float4 c3 = *reinterpret_cast<const float4*>(cst + 320 + colc);
        const float4 c4 = *reinterpret_cast<const float4*>(cst + 384 + colc);
        const float lnw[4] = {c3.x, c3.y, c3.z, c3.w}, lnb[4] = {c4.x, c4.y, c4.z, c4.w};
        float s = red16(y[0] + y[1] + y[2] + y[3]);
        float mean = s * (1.f / 64.f), vs = 0.f;
#pragma unroll
        for (int i = 0; i < 4; ++i) { y[i] -= mean; vs += y[i] * y[i]; }
        vs = red16(vs);
        float rs = rsqrtf(vs * (1.f / 64.f) + 64e-5f), bn = bonus[tk];
        float ov[4];
#pragma unroll
        for (int i = 0; i < 4; ++i) ov[i] = (y[i] * rs * lnw[i] + lnb[i] + bn * v[i]) * gg[i];
        *reinterpret_cast<uint2*>(mix + (size_t)(b * T_ + t0 + tk) * DM + 512 + h * 64 + colc) = pack4(ov[0], ov[1], ov[2], ov[3]);
      }
    }
    __syncthreads();
  }
}

__device__ __forceinline__ void phase_mixAB(KP P, unsigned char* sm) {
  volatile int& s_item = *reinterpret_cast<volatile int*>(sm + 65532);
  if (bidx() < 256) rwkv_work<0>(P, bidx() >> 2, bidx() & 3, 0, T_, sm);
  unsigned* cnt = reinterpret_cast<unsigned*>(P->ws + OFF_MISC + 64);
  for (;;) {
    __syncthreads();
    if (tidx() == 0) s_item = (int)atomicAdd(cnt, 1u);
    __syncthreads();
    int item = s_item;
    if (item >= 2048) break;
    diffattn_item(P, item, sm);
  }
  unsigned* cnt2 = reinterpret_cast<unsigned*>(P->ws + OFF_MISC + 72);
  for (;;) {
    __syncthreads();
    if (tidx() == 0) s_item = (int)atomicAdd(cnt2, 1u);
    __syncthreads();
    int v = s_item;
    if (v >= TR_TOTAL - TR_EARLY) break;
    transpose_tile(P, tr_late_tile(v), sm);
  }
}

__device__ __forceinline__ void nsa_item(KP P, int item, unsigned char* sm) {
  const int tid = tidx(), lane = tid & 63, wid = tid >> 6, c16 = lane & 15, g = lane >> 4;
  const int qblk = 127 - (item >> 4);
  const int bg = item & 15, b = bg >> 1, gg = bg & 1;
  const int t0 = qblk * 32;
  const bf16_t* p = reinterpret_cast<const bf16_t*>(P->ws + OFF_B) + (size_t)b * T_ * LDCD;
  const bf16_t* kcmp = reinterpret_cast<const bf16_t*>(P->ws + OFF_KCMP) + (size_t)bg * 256 * 64;
  const bf16_t* vcmpT = reinterpret_cast<const bf16_t*>(P->ws + OFF_VCMPT) + (size_t)bg * 64 * 256;
  const bf16_t* vts = reinterpret_cast<const bf16_t*>(P->ws + OFF_VTS) + (size_t)bg * 64 * T_;
  const bf16_t* vtw = reinterpret_cast<const bf16_t*>(P->ws + OFF_VTW) + (size_t)bg * 64 * T_;
  bf16_t* mix = reinterpret_cast<bf16_t*>(P->ws + OFF_A);
  unsigned char* Ks = sm; unsigned char* Vs = sm + 8192;
  float* psum = reinterpret_cast<float*>(sm + 16384);
  unsigned long long* selm = reinterpret_cast<unsigned long long*>(sm + 16384 + 32768);
  unsigned long long* selu = selm + 32;
  const int hh = c16 & 3;
  int tq[2];
  bf16x8 qf[2][2];
#pragma unroll
  for (int ni = 0; ni < 2; ++ni) {
    tq[ni] = t0 + wid * 8 + ni * 4 + (c16 >> 2);
#pragma unroll
    for (int ks = 0; ks < 2; ++ks)
      qf[ni][ks] = u4frag(*reinterpret_cast<const uint4*>(p + (size_t)tq[ni] * LDCD + (gg * 4 + hh) * 64 + (ks * 4 + g) * 8));
  }
  float gate[2][3];
#pragma unroll
  for (int ni = 0; ni < 2; ++ni)
#pragma unroll
    for (int br = 0; br < 3; ++br) gate[ni][br] = sigmoidf_(bf2f(p[(size_t)tq[ni] * LDCD + 1280 + (gg * 4 + hh) * 3 + br]));
  f32x4 O[4][2];
  float m[2], l[2];
  const int ncv = min(255, t0 / 16 + 1);
  const int nct = (ncv + 63) >> 6;
  for (int i = tid; i < 32 * 256; i += NTHR) psum[i] = 0.f;
  m[0] = m[1] = -1e30f; l[0] = l[1] = 0.f;
  for (int ct = 0; ct < nct; ++ct) {
    __syncthreads();
    load_tile(Ks, kcmp + (size_t)ct * 64 * 64, 64, 64);
    __syncthreads();
    f32x4 S[4][2];
#pragma unroll
    for (int mi = 0; mi < 4; ++mi) {
      S[mi][0] = f32x4{0.f, 0.f, 0.f, 0.f}; S[mi][1] = f32x4{0.f, 0.f, 0.f, 0.f};
#pragma unroll
      for (int ks = 0; ks < 2; ++ks) {
        bf16x8 kf = ldsfrag(Ks, mi * 16 + c16, ks * 4 + g);
        S[mi][0] = MFMA(kf, qf[0][ks], S[mi][0]);
        S[mi][1] = MFMA(kf, qf[1][ks], S[mi][1]);
      }
    }
#pragma unroll
    for (int ni = 0; ni < 2; ++ni) {
      float mx = -1e30f;
#pragma unroll
      for (int mi = 0; mi < 4; ++mi)
#pragma unroll
        for (int j = 0; j < 4; ++j) {
          int n = ct * 64 + mi * 16 + g * 4 + j;
          bool ok = (n < 255) && (16 * n + 31 <= tq[ni]);
          if (!ok) S[mi][ni][j] = -1e30f;
          mx = fmaxf(mx, S[mi][ni][j]);
        }
      mx = fmaxf(mx, __shfl_xor(mx, 16)); mx = fmaxf(mx, __shfl_xor(mx, 32));
      float mn = fmaxf(m[ni], mx);
      float rs = 0.f;
#pragma unroll
      for (int mi = 0; mi < 4; ++mi)
#pragma unroll
        for (int j = 0; j < 4; ++j) { float s = S[mi][ni][j]; rs += (s > -1e29f) ? ex2(s - mn) : 0.f; }
      l[ni] = l[ni] * ex2(m[ni] - mn) + rs;
      m[ni] = mn;
    }
  }
  float il[2];
#pragma unroll
  for (int ni = 0; ni < 2; ++ni) {
    l[ni] += __shfl_xor(l[ni], 16); l[ni] += __shfl_xor(l[ni], 32);
    il[ni] = (l[ni] > 0.f) ? 1.f / l[ni] : 0.f;
  }
#pragma unroll
  for (int i = 0; i < 4; ++i) { O[i][0] = f32x4{0.f, 0.f, 0.f, 0.f}; O[i][1] = f32x4{0.f, 0.f, 0.f, 0.f}; }
  for (int ct = 0; ct < nct; ++ct) {
    __syncthreads();
    load_tile(Ks, kcmp + (size_t)ct * 64 * 64, 64, 64);
    load_tile(Vs, vcmpT + ct * 64, 256, 64);
    __syncthreads();
    f32x4 S[4][2];
#pragma unroll
    for (int mi = 0; mi < 4; ++mi) {
      S[mi][0] = f32x4{0.f, 0.f, 0.f, 0.f}; S[mi][1] = f32x4{0.f, 0.f, 0.f, 0.f};
#pragma unroll
      for (int ks = 0; ks < 2; ++ks) {
        bf16x8 kf = ldsfrag(Ks, mi * 16 + c16, ks * 4 + g);
        S[mi][0] = MFMA(kf, qf[0][ks], S[mi][0]);
        S[mi][1] = MFMA(kf, qf[1][ks], S[mi][1]);
      }
    }
#pragma unroll
    for (int ni = 0; ni < 2; ++ni)
#pragma unroll
      for (int mi = 0; mi < 4; ++mi)
#pragma unroll
        for (int j = 0; j < 4; ++j) {
          int n = ct * 64 + mi * 16 + g * 4 + j;
          bool ok = (n < 255) && (16 * n + 31 <= tq[ni]);
          float pv = ok ? ex2(S[mi][ni][j] - m[ni]) * il[ni] : 0.f;
          S[mi][ni][j] = pv;
          float hs = red4(pv);
          if (hh == 0) psum[(wid * 8 + ni * 4 + (c16 >> 2)) * 256 + n] = hs;
        }
    bf16x8 pf[2][2];
#pragma unroll
    for (int ni = 0; ni < 2; ++ni) { pf[ni][0] = packfrag(S[0][ni], S[1][ni]); pf[ni][1] = packfrag(S[2][ni], S[3][ni]); }
#pragma unroll
    for (int me = 0; me < 4; ++me)
#pragma unroll
      for (int s = 0; s < 2; ++s) {
        bf16x8 vf = ldsfragP(Vs, me * 16 + c16, s, g);
        O[me][0] = MFMA(vf, pf[0][s], O[me][0]);
        O[me][1] = MFMA(vf, pf[1][s], O[me][1]);
      }
  }
#pragma unroll
  for (int ni = 0; ni < 2; ++ni)
#pragma unroll
    for (int me = 0; me < 4; ++me)
#pragma unroll
      for (int j = 0; j < 4; ++j) O[me][ni][j] *= gate[ni][0];
  __syncthreads();
  {
    unsigned long long un = 0ull;
    float* scw = reinterpret_cast<float*>(selu + 4) + wid * 64;
#pragma unroll 1
    for (int qi = 0; qi < 8; ++qi) {
      int q = wid * 8 + qi, t = t0 + q, j = lane;
      float4 a = *reinterpret_cast<const float4*>(psum + q * 256 + 4 * j);
      float imp = a.x + a.y + a.z + 0.5f * a.w;
      if (j > 0) imp += 0.5f * psum[q * 256 + 4 * j - 1];
      int cur = t >> 6;
      bool forced = (j == 0) || (j == cur) || (j == cur - 1);
      bool vld = (j * 64 <= t);
      float score = vld ? (imp + (forced ? 1e4f : 0.f)) : -1e30f;
      int rank = 0;
      scw[lane] = score;
      __builtin_amdgcn_fence(__ATOMIC_RELEASE, "wavefront");
      __builtin_amdgcn_wave_barrier();
      __builtin_amdgcn_fence(__ATOMIC_ACQUIRE, "wavefront");
#pragma unroll 4
      for (int i4 = 0; i4 < 16; ++i4) {
        float4 o = *reinterpret_cast<const float4*>(scw + i4 * 4);
        int i = i4 * 4;
        rank += (o.x > score || (o.x == score && i < j)) ? 1 : 0;
        rank += (o.y > score || (o.y == score && i + 1 < j)) ? 1 : 0;
        rank += (o.z > score || (o.z == score && i + 2 < j)) ? 1 : 0;
        rank += (o.w > score || (o.w == score && i + 3 < j)) ? 1 : 0;
      }
      __builtin_amdgcn_wave_barrier();
      unsigned long long mk = __ballot(rank < 16);
      if (lane == 0) selm[q] = mk;
      un |= mk;
    }
    if (lane == 0) selu[wid] = un;
  }
  __syncthreads();
  const unsigned long long uni = selu[0] | selu[1] | selu[2] | selu[3];
  f32x4* OUTL = reinterpret_cast<f32x4*>(psum) + tid;
#pragma unroll
  for (int ni = 0; ni < 2; ++ni)
#pragma unroll
    for (int me = 0; me < 4; ++me) OUTL[(me * 2 + ni) * 256] = O[me][ni];
  unsigned long long msk[2];
#pragma unroll
  for (int ni = 0; ni < 2; ++ni) {
    msk[ni] = selm[wid * 8 + ni * 4 + (c16 >> 2)];
    unsigned mlo = (unsigned)(msk[ni] & 0xffffffffull), mhi = (unsigned)(msk[ni] >> 32);
    asm volatile("" : "+v"(mlo), "+v"(mhi));
    msk[ni] = ((unsigned long long)mhi << 32) | mlo;
  }
  unsigned uni_lo = (unsigned)(uni & 0xffffffffull), uni_hi = (unsigned)(uni >> 32);
  asm volatile("" : "+v"(uni_lo), "+v"(uni_hi));
  unsigned char* const stg[2] = {sm, sm + 49152};
  const int jhi = t0 >> 6;
  {
#pragma unroll
    for (int i = 0; i < 4; ++i) { O[i][0] = f32x4{0.f, 0.f, 0.f, 0.f}; O[i][1] = f32x4{0.f, 0.f, 0.f, 0.f}; }
    m[0] = m[1] = 0.f; l[0] = l[1] = 0.f;
    load_tile_dma(stg[0], p + 768 + gg * 64, LDCD, 64);
    load_tile_dma(stg[0] + 8192, vts, T_, 64);
    asm volatile("s_waitcnt vmcnt(0)" ::: "memory");
    __syncthreads();
    for (int jb = 0; jb <= jhi; ++jb) {
      const int st = jb & 1;
      if (jb < jhi) {
        load_tile_dma(stg[st ^ 1], p + (size_t)((jb + 1) * 64) * LDCD + 768 + gg * 64, LDCD, 64);
        load_tile_dma(stg[st ^ 1] + 8192, vts + (jb + 1) * 64, T_, 64);
      }
      const int kbase = jb * 64;
      const bool sel0 = (msk[0] >> jb) & 1ull, sel1 = (msk[1] >> jb) & 1ull;
      if (jb == jhi) {
        flash_tile<4>(O, m, l, qf, stg[st], stg[st] + 8192, true, jb == 0, lane,
                      [&](int key, int ni) { return (ni ? sel1 : sel0) && (kbase + key <= tq[ni]); });
      } else {
        const bool allsel = __all(sel0 && sel1);
        flash_tile<4>(O, m, l, qf, stg[st], stg[st] + 8192, !allsel, jb == 0, lane,
                      [&](int key, int ni) { return ni ? sel1 : sel0; });
      }
      asm volatile("s_waitcnt vmcnt(0)" ::: "memory");
      __syncthreads();
    }
#pragma unroll
    for (int ni = 0; ni < 2; ++ni) {
      l[ni] += __shfl_xor(l[ni], 16); l[ni] += __shfl_xor(l[ni], 32);
      float sc = (l[ni] > 0.f) ? gate[ni][1] / l[ni] : 0.f;
#pragma unroll
      for (int me = 0; me < 4; ++me) {
        f32x4 a = OUTL[(me * 2 + ni) * 256];
#pragma unroll
        for (int j = 0; j < 4; ++j) a[j] += sc * O[me][ni][j];
        OUTL[(me * 2 + ni) * 256] = a;
      }
    }
  }
  {
#pragma unroll
    for (int i = 0; i < 4; ++i) { O[i][0] = f32x4{0.f, 0.f, 0.f, 0.f}; O[i][1] = f32x4{0.f, 0.f, 0.f, 0.f}; }
    m[0] = m[1] = 0.f; l[0] = l[1] = 0.f;
    const int jlo = max(0, t0 - 511) >> 6;
    load_tile_dma(stg[0], p + (size_t)(jlo * 64) * LDCD + 1024 + gg * 64, LDCD, 64);
    load_tile_dma(stg[0] + 8192, vtw + jlo * 64, T_, 64);
    asm volatile("s_waitcnt vmcnt(0)" ::: "memory");
    __syncthreads();
    for (int jb = jlo; jb <= jhi; ++jb) {
      const int st = (jb - jlo) & 1;
      if (jb < jhi) {
        load_tile_dma(stg[st ^ 1], p + (size_t)((jb + 1) * 64) * LDCD + 1024 + gg * 64, LDCD, 64);
        load_tile_dma(stg[st ^ 1] + 8192, vtw + (jb + 1) * 64, T_, 64);
      }
      const int kbase = jb * 64;
      const bool edge = (jb == jhi) || (kbase <= t0 + 31 - 512);
      flash_tile<4>(O, m, l, qf, stg[st], stg[st] + 8192, edge, jb == jlo, lane,
                    [&](int key, int ni) { int kp = kbase + key; return (kp <= tq[ni]) && (kp > tq[ni] - 512); });
      asm volatile("s_waitcnt vmcnt(0)" ::: "memory");
      __syncthreads();
    }
#pragma unroll
    for (int ni = 0; ni < 2; ++ni) {
      l[ni] += __shfl_xor(l[ni], 16); l[ni] += __shfl_xor(l[ni], 32);
      float sc = (l[ni] > 0.f) ? gate[ni][2] / l[ni] : 0.f;
#pragma unroll
      for (int me = 0; me < 4; ++me) {
        f32x4 a = OUTL[(me * 2 + ni) * 256];
#pragma unroll
        for (int j = 0; j < 4; ++j) O[me][ni][j] = a[j] + sc * O[me][ni][j];
      }
    }
  }
#pragma unroll
  for (int ni = 0; ni < 2; ++ni)
#pragma unroll
    for (int me = 0; me < 4; ++me)
      *reinterpret_cast<uint2*>(mix + (size_t)(b * T_ + tq[ni]) * DM + (gg * 4 + hh) * 64 + me * 16 + g * 4) =
          pack4(O[me][ni][0], O[me][ni][1], O[me][ni][2], O[me][ni][3]);
  __syncthreads();
}

__device__ __forceinline__ void mlstm_chain(KP P, int chain, int eh, unsigned char* sm) {
  const int tid = tidx(), lane = tid & 63, wid = tid >> 6, c16 = lane & 15, g = lane >> 4;
  const int b = chain >> 2, h = chain & 3;
  const bf16_t* p = reinterpret_cast<const bf16_t*>(P->ws + OFF_B) + (size_t)b * T_ * LDCD;
  float* hbuf = reinterpret_cast<float*>(P->ws + OFF_Y);
  const int Q0 = 1304 + h * 64, K0 = 1560 + h * 64, V0 = 1816 + h * 128 + eh * 64, I0 = 2328 + h, F0 = 2332 + h;
  unsigned char* qs = sm;
  unsigned char* ks_ = sm + 8192;
  unsigned char* kTw = sm + 16384;
  unsigned char* vTa = sm + 24576;
  unsigned char* Cs = vTa + 10240;
  float* fa = reinterpret_cast<float*>(Cs + 10240);
  float* bcum = fa; float* aarr = fa + 64; float* msv = fa + 128; float* cwv = fa + 192;
  unsigned char* rawq = sm + 46592;
  unsigned char* rawk = rawq + 8704;
  const float* convw = P->in[33]; const float* convb = P->in[34];
  const float igb = P->in[35][h], fgb = P->in[36][h];
  typedef __attribute__((address_space(3))) unsigned* ldsp_t;
  auto issue_raw = [&](int tq) {
    for (int i = tid; i < 67 * 8; i += NTHR) {
      int r = i >> 3, c = (i & 7) ^ (r & 7);
      int tk = max(tq - 3 + r, 0);
      __builtin_amdgcn_global_load_lds((const unsigned*)(p + (size_t)tk * LDCD + Q0 + c * 8), (ldsp_t)(rawq + i * 16), 16, 0, 0);
      __builtin_amdgcn_global_load_lds((const unsigned*)(p + (size_t)tk * LDCD + K0 + c * 8), (ldsp_t)(rawk + i * 16), 16, 0, 0);
    }
  };
  for (int i = tid; i < 10240 / 4; i += NTHR) reinterpret_cast<unsigned*>(Cs)[i] = 0u;
  for (int i = tid; i < 16 * 64; i += NTHR) {
    int r = 64 + (i >> 6), c = i & 63;
    *reinterpret_cast<bf16_t*>(vTa + swz(r, c >> 3) + (c & 7) * 2) = (r == 64) ? (bf16_t)0x3f80 : (bf16_t)0;
  }
  f32x4 Cst[5];
#pragma unroll
  for (int i = 0; i < 5; ++i) Cst[i] = f32x4{0.f, 0.f, 0.f, 0.f};
  float mrun = 0.f;
  bf16_t gi_raw = p[(size_t)lane * LDCD + I0], gf_raw = p[(size_t)lane * LDCD + F0];
  const int wu = __builtin_amdgcn_readfirstlane(wid);
  uint4 vraw[2];
  {
    const bf16_t* vr0 = p + (size_t)lane * LDCD + V0 + wu * 16;
    vraw[0] = *reinterpret_cast<const uint4*>(vr0); vraw[1] = *reinterpret_cast<const uint4*>(vr0 + 8);
  }
  issue_raw(0);
  asm volatile("s_waitcnt vmcnt(0)" ::: "memory");
  if (tid < 24) {
    *reinterpret_cast<uint4*>(rawq + tid * 16) = make_uint4(0, 0, 0, 0);
    *reinterpret_cast<uint4*>(rawk + tid * 16) = make_uint4(0, 0, 0, 0);
  }
  __syncthreads();
  for (int t0 = 0; t0 < T_; t0 += 64) {
    float wr, dcy, mnew;
    {
      float li = bf2f(gi_raw) + igb;
      float lf = -softplusf_(-(bf2f(gf_raw) + fgb));
      float bc = wave_scan_add(lf);
      float a = li - bc;
      float pm = wave_scan_max(a);
      float ms = bc + fmaxf(mrun, pm);
      float cw = __expf(bc + mrun - ms);
      float blast = __int_as_float(__builtin_amdgcn_readlane(__float_as_int(bc), 63));
      float amax = __int_as_float(__builtin_amdgcn_readlane(__float_as_int(pm), 63));
      mnew = blast + fmaxf(mrun, amax);
      dcy = __expf(blast + mrun - mnew);
      wr = __expf(blast + a - mnew);
      if (wid == 0) { bcum[lane] = bc; aarr[lane] = a; msv[lane] = ms; cwv[lane] = cw; }
    }
    {
      const int r = lane;
#pragma unroll 1
      for (int which = 0; which < 2; ++which) {
        const unsigned char* raw = which ? rawk : rawq;
        const int chb = which * 256 + h * 64 + wu * 16;
        float qa[16];
#pragma unroll
        for (int i = 0; i < 16; ++i) qa[i] = convb[chb + i];
#pragma unroll
        for (int jj = 0; jj < 4; ++jj) {
          const int ri = r + jj;
          uint4 q0 = *reinterpret_cast<const uint4*>(raw + swz(ri, wu * 2)), q1 = *reinterpret_cast<const uint4*>(raw + swz(ri, wu * 2 + 1));
          const unsigned qw[8] = {q0.x, q0.y, q0.z, q0.w, q1.x, q1.y, q1.z, q1.w};
#pragma unroll
          for (int i = 0; i < 16; ++i)
            qa[i] += bf2f((unsigned short)(qw[i >> 1] >> ((i & 1) * 16))) * convw[jj * 512 + chb + i];
        }
        const float sc = which ? 1.f : 0.125f;
#pragma unroll
        for (int i = 0; i < 16; ++i) qa[i] = qa[i] * sigmoidf_(qa[i]) * sc;
        unsigned char* dstt = which ? ks_ : qs;
#pragma unroll
        for (int c = 0; c < 2; ++c)
          *reinterpret_cast<uint4*>(dstt + swz(r, wu * 2 + c)) = make_uint4(pack2(qa[c * 8], qa[c * 8 + 1]), pack2(qa[c * 8 + 2], qa[c * 8 + 3]),
                                                                         pack2(qa[c * 8 + 4], qa[c * 8 + 5]), pack2(qa[c * 8 + 6], qa[c * 8 + 7]));
        if (which) {
#pragma unroll
          for (int i = 0; i < 16; ++i) {
            int d = wu * 16 + i;
            *reinterpret_cast<bf16_t*>(kTw + swz(d, r >> 3) + (r & 7) * 2) = f2bf(qa[i] * wr);
          }
        }
      }
#pragma unroll
      for (int c = 0; c < 2; ++c) {
        const unsigned vw[4] = {vraw[c].x, vraw[c].y, vraw[c].z, vraw[c].w};
#pragma unroll
        for (int i = 0; i < 8; ++i) {
          int e = wu * 16 + c * 8 + i;
          *reinterpret_cast<bf16_t*>(vTa + swz(e, r >> 3) + (r & 7) * 2) = (bf16_t)(vw[i >> 1] >> ((i & 1) * 16));
        }
      }
    }
    __syncthreads();
    if (t0 + 64 < T_) {
      issue_raw(t0 + 64);
      const bf16_t* pr = p + (size_t)(t0 + 64 + lane) * LDCD;
      gi_raw = pr[I0]; gf_raw = pr[F0];
      vraw[0] = *reinterpret_cast<const uint4*>(pr + V0 + wu * 16); vraw[1] = *reinterpret_cast<const uint4*>(pr + V0 + wu * 16 + 8);
    }
    {
      const int s = wu * 16 + c16;
      bf16x8 qf[2] = {ldsfrag(qs, s, g), ldsfrag(qs, s, 4 + g)};
      f32x4 S[4];
#pragma unroll
      for (int mi = 0; mi < 4; ++mi) {
        S[mi] = f32x4{0.f, 0.f, 0.f, 0.f};
        if (mi <= wu) {
          S[mi] = MFMA(ldsfrag(ks_, mi * 16 + c16, g), qf[0], S[mi]);
          S[mi] = MFMA(ldsfrag(ks_, mi * 16 + c16, 4 + g), qf[1], S[mi]);
        }
      }
      const float bs = bcum[s], mss = msv[s], cws = cwv[s];
#pragma unroll
      for (int mi = 0; mi < 4; ++mi)
#pragma unroll
        for (int j = 0; j < 4; ++j) {
          int r = mi * 16 + g * 4 + j;
          float wgt = __expf((r <= s) ? (bs + aarr[r] - mss) : -100.f);
          S[mi][j] *= wgt;
        }
      bf16x8 pf[2] = {packfrag(S[0], S[1]), packfrag(S[2], S[3])};
      f32x4 acc[5];
#pragma unroll
      for (int me = 0; me < 5; ++me) {
        acc[me] = f32x4{0.f, 0.f, 0.f, 0.f};
        acc[me] = MFMA(ldsfrag(Cs, me * 16 + c16, g), qf[0], acc[me]);
        acc[me] = MFMA(ldsfrag(Cs, me * 16 + c16, 4 + g), qf[1], acc[me]);
        acc[me][0] *= cws; acc[me][1] *= cws; acc[me][2] *= cws; acc[me][3] *= cws;
        acc[me] = MFMA(ldsfragP(vTa, me * 16 + c16, 0, g), pf[0], acc[me]);
        if (wu >= 2) acc[me] = MFMA(ldsfragP(vTa, me * 16 + c16, 1, g), pf[1], acc[me]);
      }
      float den = __shfl(acc[4][0], c16);
      float hd = 1.f / fmaxf(fabsf(den), __expf(-mss));
      float* hrow = hbuf + (size_t)(b * T_ + t0 + s) * 512 + h * 128 + eh * 64;
#pragma unroll
      for (int me = 0; me < 4; ++me)
        *reinterpret_cast<float4*>(hrow + me * 16 + g * 4) = make_float4(acc[me][0] * hd, acc[me][1] * hd, acc[me][2] * hd, acc[me][3] * hd);
    }
    {
      bf16x8 kf0 = ldsfragP(kTw, wu * 16 + c16, 0, g), kf1 = ldsfragP(kTw, wu * 16 + c16, 1, g);
#pragma unroll
      for (int me = 0; me < 5; ++me) {
        Cst[me][0] *= dcy; Cst[me][1] *= dcy; Cst[me][2] *= dcy; Cst[me][3] *= dcy;
        Cst[me] = MFMA(ldsfragP(vTa, me * 16 + c16, 0, g), kf0, Cst[me]);
        Cst[me] = MFMA(ldsfragP(vTa, me * 16 + c16, 1, g), kf1, Cst[me]);
      }
    }
    mrun = mnew;
    asm volatile("s_waitcnt vmcnt(0)" ::: "memory");
    __syncthreads();
    {
      const int d = wu * 16 + c16;
#pragma unroll
      for (int me = 0; me < 5; ++me)
#pragma unroll
        for (int j = 0; j < 4; ++j) {
          int e = me * 16 + g * 4 + j;
          *reinterpret_cast<bf16_t*>(Cs + swz(e, d >> 3) + (d & 7) * 2) = f2bf(Cst[me][j]);
        }
    }
  }
  __syncthreads();
}

__device__ __forceinline__ void phase_mlstm_post(KP P) {
  const int tid = tidx(), lane = tid & 63, wid = tid >> 6;
  const float* hbuf = reinterpret_cast<const float*>(P->ws + OFF_Y);
  const bf16_t* pb = reinterpret_cast<const bf16_t*>(P->ws + OFF_B);
  bf16_t* mix = reinterpret_cast<bf16_t*>(P->ws + OFF_A);
  const float* normw = P->in[37];
  for (int task = bidx() * 4 + wid; task < MTOK * 4; task += gridDim.x * 4) {
    const int tok = task >> 2, h = task & 3;
    float2 hv = *reinterpret_cast<const float2*>(hbuf + (size_t)tok * 512 + h * 128 + lane * 2);
    unsigned ogu = *reinterpret_cast<const unsigned*>(pb + (size_t)tok * LDCD + 2336 + h * 128 + lane * 2);
    float2 nw = *reinterpret_cast<const float2*>(normw + h * 128 + lane * 2);
    float ss = hv.x * hv.x + hv.y * hv.y;
    for (int o = 32; o; o >>= 1) ss += __shfl_xor(ss, o);
    float rn = rsqrtf(ss * (1.f / 128.f) + 1e-6f);
    float o0 = hv.x * rn * nw.x * sigmoidf_(bf2f((unsigned short)(ogu & 0xffff)));
    float o1 = hv.y * rn * nw.y * sigmoidf_(bf2f((unsigned short)(ogu >> 16)));
    *reinterpret_cast<unsigned*>(mix + (size_t)tok * DM + 512 + h * 128 + lane * 2) = pack2(o0, o1);
  }
}

__device__ __forceinline__ void phase_mixCD(KP P, unsigned char* sm) {
  volatile int& s_item2 = *reinterpret_cast<volatile int*>(sm + 65532);
  if (bidx() < 64) mlstm_chain(P, bidx() >> 1, bidx() & 1, sm);
  unsigned* cnt = reinterpret_cast<unsigned*>(P->ws + OFF_MISC + 68);
  for (;;) {
    __syncthreads();
    if (tidx() == 0) s_item2 = (int)atomicAdd(cnt, 1u);
    __syncthreads();
    int item = s_item2;
    if (item >= 2048) break;
    nsa_item(P, item, sm);
  }
}


#define XB_TMO      128
#define XB_XCNT(j)  (256  + 64 * (j))
#define XB_XSUB(j)  (1280 + 64 * (j))
#define XB_XGEN(j)  (2304 + 64 * (j))
#define XB_TOP      3328
#define XB_TOPGEN   3392
#define XCD_BAR_WORDS 3456
#define XB_SPIN_CAP (1u << 22)
__device__ __forceinline__ unsigned xb_ld(unsigned* p) { return __hip_atomic_load(p, __ATOMIC_RELAXED, __HIP_MEMORY_SCOPE_AGENT); }
__device__ __forceinline__ unsigned xb_add(unsigned* p, unsigned v) { return __hip_atomic_fetch_add(p, v, __ATOMIC_RELAXED, __HIP_MEMORY_SCOPE_AGENT); }
__device__ __forceinline__ unsigned xb_xcc_id() { return (unsigned)__builtin_amdgcn_s_getreg((3 << 11) | 20) & 0xFu; }
#define XB_SPIN(cond, bar) do { unsigned _sp = 0; while (cond) { __builtin_amdgcn_s_sleep(1); \
    if ((++_sp & 255u) == 0u) { if (xb_ld(&(bar)[XB_TMO])) break; if (_sp > XB_SPIN_CAP) { atomicAdd(&(bar)[XB_TMO], 1u); break; } } } } while (0)
struct XcdBarrier { unsigned x, nloc, nx; };
__device__ __forceinline__ void xcd_barrier_complete(unsigned* bar, unsigned x, unsigned& nloc, unsigned& nx) {
  const unsigned G = gridDim.x;
  unsigned sum, cnt, mine, sp = 0u;
  for (;;) {
    sum = 0u; cnt = 0u; mine = 0u;
#pragma unroll
    for (unsigned j = 0; j < 16; ++j) { const unsigned c = xb_ld(&bar[XB_XCNT(j)]); sum += c; cnt += (c > 0u) ? 1u : 0u; mine = (j == x) ? c : mine; }
    if (sum == G) break;
    __builtin_amdgcn_s_sleep(1);
    if ((++sp & 255u) == 0u) { if (xb_ld(&bar[XB_TMO])) break; if (sp > XB_SPIN_CAP) { atomicAdd(&bar[XB_TMO], 1u); break; } }
  }
  nloc = mine > 0u ? mine : 1u; nx = cnt > 0u ? cnt : 1u;
}
__device__ __forceinline__ void xcd_barrier(XcdBarrier& b, KP kpp) {
  asm volatile("s_waitcnt vmcnt(0)" ::: "memory");
  __syncthreads();
  if (threadIdx.x == 0) {
    unsigned* bar = reinterpret_cast<unsigned*>(kp_launder(kpp)->ws + OFF_XBAR);
    __builtin_amdgcn_s_waitcnt(0);
    if (b.nloc == 0u) xcd_barrier_complete(bar, b.x, b.nloc, b.nx);
    const unsigned nloc = b.nloc, nx = b.nx;
    const unsigned old = xb_add(&bar[XB_XSUB(b.x)], 1u);
    const unsigned gen = old / nloc;
    if (old + 1u == (gen + 1u) * nloc) {
      __builtin_amdgcn_fence(__ATOMIC_RELEASE, "agent");
      asm volatile("s_waitcnt vmcnt(0)" ::: "memory");
      const unsigned og = xb_add(&bar[XB_TOP], 1u);
      const unsigned tg = og / nx;
      if (og + 1u == (tg + 1u) * nx) xb_add(&bar[XB_TOPGEN], 1u);
      else XB_SPIN(xb_ld(&bar[XB_TOPGEN]) == tg, bar);
      __builtin_amdgcn_fence(__ATOMIC_ACQUIRE, "agent");
      xb_add(&bar[XB_XGEN(b.x)], 1u);
      asm volatile("s_waitcnt vmcnt(0)" ::: "memory");
    } else {
      XB_SPIN(xb_ld(&bar[XB_XGEN(b.x)]) == gen, bar);
      __builtin_amdgcn_fence(__ATOMIC_ACQUIRE, "agent");
      asm volatile("s_waitcnt vmcnt(0)" ::: "memory");
    }
  }
  __syncthreads();
}

constexpr int NPHASE = 24;
enum { OP_RWKVPOST = 13, OP_MLSTMPOST = 14, OP_PREP = 0, OP_FNORM, OP_GATEUP, OP_DOWN, OP_MNORM, OP_WINAB, OP_MIXAB, OP_WOUT, OP_WINCD, OP_CMP1, OP_CMP2, OP_MIXCD, OP_FINAL };
template <int op>
__device__ __forceinline__ void run_op(KP P, const int f, unsigned char* sm) {
  unsigned char* ws = P->ws;
  bf16_t* xn = reinterpret_cast<bf16_t*>(ws + OFF_A);
  bf16_t* bufB = reinterpret_cast<bf16_t*>(ws + OFF_B);
  const float2* rope = reinterpret_cast<const float2*>(ws + OFF_ROPE);
  float* xres = P->out;
  switch (op) {
    case OP_PREP: phase_prep(P, sm); break;
    case OP_FNORM: {
      int layer = f >> 1; bool bsel = f & 1;
      const float* src = (f == 0) ? P->in[0] : xres;
      phase_rmsnorm(src, (bsel ? P->in[6] : P->in[1]) + layer * DM, xn);
    } break;
    case OP_GATEUP: {
      ALoadPlain al{xn, DM};
      EpiGateUp ep{bufB};
      gemm_phase(al, reinterpret_cast<const bf16_t*>(ws + OFF_WGU + f * SZ_WGU), DM, MTOK / 256, 44, ep, sm);
    } break;
    case OP_DOWN: {
      ALoadPlain al{bufB, FF};
      EpiResid ep{(f == 0) ? P->in[0] : xres, xres, 0.5f};
      gemm_phase(al, reinterpret_cast<const bf16_t*>(ws + OFF_WD + f * SZ_WD), FF, MTOK / 256, 8, ep, sm);
    } break;
    case OP_MNORM: phase_rmsnorm(xres, P->in[5] + f * DM, xn); break;
    case OP_WINAB: { ALoadPlain al{xn, DM}; EpiWinAB ep{bufB, reinterpret_cast<bf16_t*>(ws + OFF_C), rope};
              gemm_phase(al, reinterpret_cast<const bf16_t*>(ws + OFF_WINAB), DM, MTOK / 256, 26, ep, sm); } break;
    case OP_MIXAB: phase_mixAB(P, sm); break;
    case OP_RWKVPOST:
      for (int task = bidx(); task < 1024; task += gridDim.x) rwkv_work<1>(P, task >> 4, 0, (task & 15) * 256, (task & 15) * 256 + 256, sm);
      break;
    case OP_WOUT: { ALoadPlain al{xn, DM}; EpiResid ep{xres, xres, 1.f};
              gemm_phase(al, reinterpret_cast<const bf16_t*>(ws + (f ? OFF_WOUTCD : OFF_WOUTAB)), DM, MTOK / 256, 8, ep, sm); } break;
    case OP_WINCD: { ALoadPlain al{xn, DM};
               EpiWinCD ep{bufB, reinterpret_cast<bf16_t*>(ws + OFF_VTS), reinterpret_cast<bf16_t*>(ws + OFF_VTW), rope};
               gemm_phase(al, reinterpret_cast<const bf16_t*>(ws + OFF_WINCD), DM, MTOK / 256, 23, ep, sm); } break;
    case OP_CMP1: {
      const float* bias = reinterpret_cast<const float*>(ws + OFF_BIAS1);
      (void)bias;
      for (int i = bidx(); i < 256; i += gridDim.x) {
        int kv = i >> 7, sp = (i >> 5) & 3, r = i & 31, tm = r >> 1, tn = r & 1;
        ALoadCmp al{bufB, kv ? 640 : 512, sp * 8};
        EpiCmp1P ep{reinterpret_cast<float*>(ws + OFF_Y) + ((size_t)(kv * 4 + sp) * 4096) * 256};
        gemm_tile(al, reinterpret_cast<const bf16_t*>(ws + (kv ? OFF_W1V : OFF_W1K)) + sp * 512, 512, tm, tn, ep, sm, false, -1, -1, 2048);
      }
    } break;
    case OP_CMP2: {
      phase_cmp2(P, rope);
    } break;
    case OP_MIXCD: phase_mixCD(P, sm); break;
    case OP_FINAL: phase_finalnorm(xres, P->in[38]); break;
    case OP_MLSTMPOST: phase_mlstm_post(P); break;
  }
}

#if MEGA
#define GSYNC xcd_barrier(xb, kp)
__global__ void __launch_bounds__(NTHR, 2) mega_kernel(Params P) {
  __shared__ __attribute__((aligned(16))) unsigned char sm[65536];
  cg::grid_group grid = cg::this_grid();
  KP kp = (KP)__builtin_amdgcn_kernarg_segment_ptr();
  run_op<OP_PREP>(kp_launder(kp), 0, sm);
  run_op<OP_FNORM>(kp_launder(kp), 0, sm);
  grid.sync();
  XcdBarrier xb;
  xb.x = xb_xcc_id(); xb.nloc = 0u; xb.nx = 0u;
  if (threadIdx.x == 0) (void)xb_add(&reinterpret_cast<unsigned*>(kp->ws + OFF_XBAR)[XB_XCNT(xb.x)], 1u);
  run_op<OP_GATEUP>(kp_launder(kp), 0, sm); GSYNC;
  run_op<OP_DOWN>(kp_launder(kp), 0, sm); GSYNC;
  run_op<OP_MNORM>(kp_launder(kp), 0, sm); GSYNC;
  run_op<OP_WINAB>(kp_launder(kp), 0, sm); GSYNC;
  run_op<OP_MIXAB>(kp_launder(kp), 0, sm); GSYNC;
  run_op<OP_RWKVPOST>(kp_launder(kp), 0, sm); GSYNC;
  run_op<OP_WOUT>(kp_launder(kp), 0, sm); GSYNC;
  run_op<OP_FNORM>(kp_launder(kp), 1, sm); GSYNC;
  run_op<OP_GATEUP>(kp_launder(kp), 1, sm); GSYNC;
  run_op<OP_DOWN>(kp_launder(kp), 1, sm); GSYNC;
  run_op<OP_FNORM>(kp_launder(kp), 2, sm); GSYNC;
  run_op<OP_GATEUP>(kp_launder(kp), 2, sm); GSYNC;
  run_op<OP_DOWN>(kp_launder(kp), 2, sm); GSYNC;
  run_op<OP_MNORM>(kp_launder(kp), 1, sm); GSYNC;
  run_op<OP_WINCD>(kp_launder(kp), 0, sm); GSYNC;
  run_op<OP_CMP1>(kp_launder(kp), 0, sm); GSYNC;
  run_op<OP_CMP2>(kp_launder(kp), 0, sm); GSYNC;
  run_op<OP_MIXCD>(kp_launder(kp), 0, sm); GSYNC;
  run_op<OP_MLSTMPOST>(kp_launder(kp), 0, sm); GSYNC;
  run_op<OP_WOUT>(kp_launder(kp), 1, sm); GSYNC;
  run_op<OP_FNORM>(kp_launder(kp), 3, sm); GSYNC;
  run_op<OP_GATEUP>(kp_launder(kp), 3, sm); GSYNC;
  run_op<OP_DOWN>(kp_launder(kp), 3, sm); GSYNC;
  run_op<OP_FINAL>(kp_launder(kp), 0, sm);
}
#else
template <int OP>
__global__ void __launch_bounds__(NTHR, 2) phase_kernel(Params P, int f) {
  __shared__ __attribute__((aligned(16))) unsigned char sm[65536];
  run_op<OP>((KP)__builtin_amdgcn_kernarg_segment_ptr(), f, sm);
}
#endif

extern "C" void kernel_launch(void* const* d_in, const int* in_sizes, int n_in, void* d_out, int out_size, void* d_ws,
                              size_t ws_size, hipStream_t stream) {
  Params P;
  memset(&P, 0, sizeof(P));
  for (int i = 0; i < 39; ++i) P.in[i] = (const float*)d_in[i];
  P.out = (float*)d_out;
  P.ws = (unsigned char*)d_ws;
#if MEGA
  static int grid_blocks = 0;
  if (!grid_blocks) {
    int dev = 0, cus = 0, per_cu = 0;
    (void)hipGetDevice(&dev);
    (void)hipDeviceGetAttribute(&cus, hipDeviceAttributeMultiprocessorCount, dev);
    (void)hipOccupancyMaxActiveBlocksPerMultiprocessor(&per_cu, mega_kernel, NTHR, 0);
    if (per_cu > 2) per_cu = 2;
    if (per_cu < 1) per_cu = 1;
    grid_blocks = cus * per_cu;
  }
  void* args[] = {&P};
  hipError_t e = hipLaunchCooperativeKernel((void*)mega_kernel, dim3(grid_blocks), dim3(NTHR), args, 0, stream);
  if (e != hipSuccess) fprintf(stderr, "cooperative launch failed: %s (grid %d)\n", hipGetErrorString(e), grid_blocks);
#else
#define LP(OP, F) phase_kernel<OP><<<512, NTHR, 0, stream>>>(P, F)
  LP(OP_PREP, 0);
  for (int layer = 0; layer < 2; ++layer) {
    LP(OP_FNORM, 2 * layer); LP(OP_GATEUP, 2 * layer); LP(OP_DOWN, 2 * layer); LP(OP_MNORM, layer);
    if (layer == 0) { LP(OP_WINAB, 0); LP(OP_MIXAB, 0); LP(OP_RWKVPOST, 0); }
    else { LP(OP_WINCD, 0); LP(OP_CMP1, 0); LP(OP_CMP2, 0); LP(OP_MIXCD, 0); LP(OP_MLSTMPOST, 0); }
    LP(OP_WOUT, layer); LP(OP_FNORM, 2 * layer + 1); LP(OP_GATEUP, 2 * layer + 1); LP(OP_DOWN, 2 * layer + 1);
  }
  LP(OP_FINAL, 0);
#endif
}
```
